# Optimizing an MI355X kernel written in HIP

```python
import math
import jax
import jax.numpy as jnp
from jax import lax
import numpy as np

D_MODEL = 2048
BATCH = 4
SEQ = 4096
DEPTH = 2

N_MEM = 256
MEM_HEADS = 4
MEM_HEAD_DIM = D_MODEL // MEM_HEADS
D_FF = ((8 * D_MODEL // 3 + 255) // 256) * 256
MACARON_WEIGHT = 0.5
HYENA_WIDTH = D_MODEL // 2
HYENA_ORDER = 2
HYENA_SHORT_CONV = 3
FILTER_EMB_DIM = 33
FILTER_BANDS = (FILTER_EMB_DIM - 1) // 2
FILTER_HIDDEN = 64
DECAY_TARGET = 1e-2
FAST_DECAY_PCT = 0.3
SLOW_DECAY_PCT = 1.5
N_DIRECTIONS = 2
FNET_WIDTH = D_MODEL // 4
FNET_GROUPS = 4
FNET_GROUP = FNET_WIDTH // FNET_GROUPS
POOL_WINDOWS = (2, 4, 8, 16)
N_POOL = len(POOL_WINDOWS)
POOL_WIDTH = D_MODEL // 4
POOL_GROUP = POOL_WIDTH // N_POOL
POOL_OUT_GROUP = D_MODEL // N_POOL
N_BRANCH = 3
HYENA_COLS = (1 + HYENA_ORDER) * HYENA_WIDTH
FNET_START = HYENA_COLS
POOL_START = FNET_START + FNET_WIDTH
GATE_START = POOL_START + POOL_WIDTH
IN_COLS = GATE_START + N_BRANCH * D_MODEL
RMS_EPS = 1e-6

kernel_name = 'hybrid_hyena_fnet_pool_encoder'


def rms_norm(x, g):
    xf = x.astype(jnp.float32)
    y = xf * lax.rsqrt(jnp.mean(xf * xf, axis=-1, keepdims=True) + RMS_EPS)
    return (y * g.astype(jnp.float32)).astype(x.dtype)


def half_step_swiglu(x, g_pre, w_gu, w_down, g_post):
    a, b = jnp.split(rms_norm(x, g_pre) @ w_gu, 2, axis=-1)
    return x + MACARON_WEIGHT * rms_norm((jax.nn.silu(a) * b) @ w_down, g_post)


def centred_short_conv(u, w, b):
    L = u.shape[1]
    pad = HYENA_SHORT_CONV // 2
    up = jnp.pad(u, ((0, 0), (pad, HYENA_SHORT_CONV - 1 - pad), (0, 0)))
    y = b + up[:, 0:L] * w[0]
    for j in range(1, HYENA_SHORT_CONV):
        y = y + up[:, j:j + L] * w[j]
    return y


def hyena_filter_spectrum(L, fw1, fb1, fw2, fb2, fw3, fb3, fw4, freq):
    f32 = jnp.float32
    t = jnp.linspace(0.0, 1.0, L, dtype=f32)[:, None]
    bands = jnp.linspace(1e-4, FILTER_BANDS - 1, FILTER_BANDS, dtype=f32)
    ang = (2.0 * math.pi / L) * jnp.arange(L, dtype=f32)[:, None] * bands[None, :]
    z = jnp.concatenate([t, jnp.cos(ang), -jnp.sin(ang)], axis=-1)
    fr = freq.astype(f32)
    h = jnp.sin(fr * (z @ fw1.astype(f32) + fb1.astype(f32)))
    h = jnp.sin(fr * (h @ fw2.astype(f32) + fb2.astype(f32)))
    h = jnp.sin(fr * (h @ fw3.astype(f32) + fb3.astype(f32)))
    h = (h @ fw4.astype(f32)).reshape(L, HYENA_ORDER, N_DIRECTIONS, HYENA_WIDTH)
    max_decay = math.log(DECAY_TARGET) / FAST_DECAY_PCT
    min_decay = math.log(DECAY_TARGET) / SLOW_DECAY_PCT
    deltas = jnp.abs(jnp.linspace(min_decay, max_decay, HYENA_WIDTH, dtype=f32))
    h = h * jnp.exp(-t * deltas)[:, None, None, :]
    fwd = h[:, :, 0]
    bwd = h[:, :, 1]
    two_sided = jnp.concatenate(
        [fwd, jnp.zeros((1, HYENA_ORDER, HYENA_WIDTH), f32), bwd[:0:-1]], axis=0)
    return jnp.fft.rfft(two_sided, axis=0)


def two_sided_fft_conv(z, spec):
    L = z.shape[1]
    zf = jnp.fft.rfft(z, n=2 * L, axis=1)
    return jnp.fft.irfft(zf * spec[None], n=2 * L, axis=1)[:, :L]


def hyena_branch(hy, spec, d_skip):
    parts = jnp.split(hy, 1 + HYENA_ORDER, axis=-1)
    z = parts[0]
    for o in range(HYENA_ORDER):
        z = parts[1 + o] * (two_sided_fft_conv(z, spec[:, o]) + z * d_skip[o])
    return z


def fnet_branch(f):
    B, L, _ = f.shape
    fg = f.astype(jnp.float32).reshape(B, L, FNET_GROUPS, FNET_GROUP)
    y = jnp.fft.fftn(fg, axes=(1, 3), norm='ortho').real
    return y.reshape(B, L, FNET_WIDTH).astype(f.dtype)


def pool_branch(p, w_pool, scale):
    B, L, _ = p.shape
    pg = p.astype(jnp.float32).reshape(B, L, N_POOL, POOL_GROUP)
    csum = jnp.pad(jnp.cumsum(pg, axis=1), ((0, 0), (1, 0), (0, 0), (0, 0)))
    pos = jnp.arange(L)
    outs = []
    for g, w in enumerate(POOL_WINDOWS):
        before = w // 2
        after = w - 1 - before
        lo = jnp.clip(pos - before, 0, L - 1)
        hi = jnp.clip(pos + after, 0, L - 1)
        window_sum = jnp.take(csum[:, :, g], hi + 1, axis=1) - jnp.take(csum[:, :, g], lo, axis=1)
        count = (hi - lo + 1).astype(jnp.float32)[None, :, None]
        outs.append(window_sum / count - pg[:, :, g])
    m = jnp.stack(outs, axis=2).astype(p.dtype)
    y = jnp.einsum('blgc,gcd->blgd', m, w_pool).reshape(B, L, N_POOL * POOL_OUT_GROUP)
    return y * scale


def memory_cross_attention(h, m, w_q, w_kv, w_o):
    B, L, D = h.shape
    q = (h @ w_q).reshape(B, L, MEM_HEADS, MEM_HEAD_DIM)
    kv = (m @ w_kv).reshape(B, m.shape[1], 2, MEM_HEADS, MEM_HEAD_DIM)
    k = kv[:, :, 0]
    v = kv[:, :, 1]
    s = jnp.einsum('bqhd,bkhd->bhqk', q, k, preferred_element_type=jnp.float32)
    p = jax.nn.softmax(s * (MEM_HEAD_DIM ** -0.5), axis=-1).astype(h.dtype)
    o = jnp.einsum('bhqk,bkhd->bqhd', p, v).reshape(B, L, D)
    return o @ w_o


def setup_inputs(seed: int = 0) -> dict:
    key = jax.random.key(seed)
    keys = iter(jax.random.split(key, 40))
    f32 = jnp.float32

    def nrm(shape, scale):
        return scale * jax.random.normal(next(keys), shape, f32)

    def gain(shape):
        return 1.0 + 0.05 * jax.random.normal(next(keys), shape, f32)

    Lr = DEPTH
    D = D_MODEL
    return {
        'x': nrm((BATCH, SEQ, D), 1.0),
        'mem': nrm((BATCH, N_MEM, D), 1.0),
        'g_ffn1_pre': gain((Lr, D)),
        'w_ffn1_gu': nrm((Lr, D, 2 * D_FF), D ** -0.5),
        'w_ffn1_down': nrm((Lr, D_FF, D), D_FF ** -0.5),
        'g_ffn1_post': gain((Lr, D)),
        'g_mix_pre': gain((Lr, D)),
        'w_in': nrm((Lr, D, IN_COLS), D ** -0.5),
        'hyena_conv_w': nrm((Lr, HYENA_SHORT_CONV, HYENA_COLS), HYENA_SHORT_CONV ** -0.5),
        'hyena_conv_b': nrm((Lr, HYENA_COLS), 0.02),
        'filt_w1': nrm((Lr, FILTER_EMB_DIM, FILTER_HIDDEN), FILTER_EMB_DIM ** -0.5),
        'filt_b1': nrm((Lr, FILTER_HIDDEN), 0.02),
        'filt_w2': nrm((Lr, FILTER_HIDDEN, FILTER_HIDDEN), FILTER_HIDDEN ** -0.5),
        'filt_b2': nrm((Lr, FILTER_HIDDEN), 0.02),
        'filt_w3': nrm((Lr, FILTER_HIDDEN, FILTER_HIDDEN), FILTER_HIDDEN ** -0.5),
        'filt_b3': nrm((Lr, FILTER_HIDDEN), 0.02),
        'filt_w4': nrm((Lr, FILTER_HIDDEN, HYENA_ORDER * N_DIRECTIONS * HYENA_WIDTH),
                       0.05 * FILTER_HIDDEN ** -0.5),
        'filt_freq': gain((Lr, FILTER_HIDDEN)),
        'hyena_d': nrm((Lr, HYENA_ORDER, HYENA_WIDTH), 0.5),
        'w_hyena_out': nrm((Lr, HYENA_WIDTH, D), HYENA_WIDTH ** -0.5),
        'w_fnet_out': nrm((Lr, FNET_WIDTH, D), FNET_WIDTH ** -0.5),
        'w_pool': nrm((Lr, N_POOL, POOL_GROUP, POOL_OUT_GROUP), POOL_GROUP ** -0.5),
        'pool_scale': gain((Lr, D)),
        'w_out': nrm((Lr, D, D), D ** -0.5),
        'g_mix_post': gain((Lr, D)),
        'g_mem_pre': gain((Lr, D)),
        'g_mem_kv': gain((Lr, D)),
        'w_q': nrm((Lr, D, D), D ** -0.5),
        'w_kv': nrm((Lr, D, 2 * D), D ** -0.5),
        'w_o': nrm((Lr, D, D), D ** -0.5),
        'g_mem_post': gain((Lr, D)),
        'g_ffn2_pre': gain((Lr, D)),
        'w_ffn2_gu': nrm((Lr, D, 2 * D_FF), D ** -0.5),
        'w_ffn2_down': nrm((Lr, D_FF, D), D_FF ** -0.5),
        'g_ffn2_post': gain((Lr, D)),
    }


def reference(x, mem, g_ffn1_pre, w_ffn1_gu, w_ffn1_down, g_ffn1_post, g_mix_pre, w_in,
              hyena_conv_w, hyena_conv_b, filt_w1, filt_b1, filt_w2, filt_b2, filt_w3, filt_b3,
              filt_w4, filt_freq, hyena_d, w_hyena_out, w_fnet_out, w_pool, pool_scale, w_out,
              g_mix_post, g_mem_pre, g_mem_kv, w_q, w_kv, w_o, g_mem_post,
              g_ffn2_pre, w_ffn2_gu, w_ffn2_down, g_ffn2_post):
    dt = x.dtype
    B, L, D = x.shape
    for l in range(DEPTH):
        x = half_step_swiglu(x, g_ffn1_pre[l], w_ffn1_gu[l], w_ffn1_down[l], g_ffn1_post[l])

        u = rms_norm(x, g_mix_pre[l])
        proj = u @ w_in[l]
        hy = proj[..., :FNET_START]
        fn = proj[..., FNET_START:POOL_START]
        po = proj[..., POOL_START:GATE_START]
        gates = jax.nn.sigmoid(proj[..., GATE_START:].astype(jnp.float32))
        gates = gates.reshape(B, L, N_BRANCH, D).astype(dt)

        hy = centred_short_conv(hy, hyena_conv_w[l], hyena_conv_b[l]).astype(jnp.float32)
        spec = hyena_filter_spectrum(L, filt_w1[l], filt_b1[l], filt_w2[l], filt_b2[l],
                                     filt_w3[l], filt_b3[l], filt_w4[l], filt_freq[l])
        y_a = hyena_branch(hy, spec, hyena_d[l].astype(jnp.float32)).astype(dt) @ w_hyena_out[l]
        y_b = fnet_branch(fn) @ w_fnet_out[l]
        y_c = pool_branch(po, w_pool[l], pool_scale[l])

        merged = gates[:, :, 0] * y_a + gates[:, :, 1] * y_b + gates[:, :, 2] * y_c
        x = x + rms_norm(merged @ w_out[l], g_mix_post[l])

        h = rms_norm(x, g_mem_pre[l])
        m = rms_norm(mem, g_mem_kv[l])
        x = x + rms_norm(memory_cross_attention(h, m, w_q[l], w_kv[l], w_o[l]), g_mem_post[l])

        x = half_step_swiglu(x, g_ffn2_pre[l], w_ffn2_gu[l], w_ffn2_down[l], g_ffn2_post[l])
    return x
```

```cpp
#include <hip/hip_runtime.h>
#include <hip/hip_cooperative_groups.h>
#include <cstdio>
namespace cg = cooperative_groups;

#define LAS __attribute__((address_space(3)))
typedef unsigned short bf16_t;
typedef short bf16x8 __attribute__((ext_vector_type(8)));
typedef float f32x4 __attribute__((ext_vector_type(4)));
typedef float f32x2 __attribute__((ext_vector_type(2)));
typedef unsigned u32x4 __attribute__((ext_vector_type(4)));
typedef unsigned u32x2 __attribute__((ext_vector_type(2)));

constexpr int NTOK = 16384, DM = 2048, DFF = 5632, SEQ = 4096, NB = 4, MEMROWS = 1024;
constexpr int NIN = 35;
constexpr float RMS_EPS = 1e-6f;
constexpr float F8_SA = 16.0f, F8_SW = 512.0f, F8_SH = 8.0f;
constexpr int LDS_BYTES = 137216;

constexpr size_t E_WGU = 23068672, E_WD = 11534336, E_WINT = 8388608, E_WINN = 13631488, E_WM = 5242880, E_SQ = 4194304;
constexpr size_t O_WGU1 = 0, O_WD1 = O_WGU1 + 2 * E_WGU, O_WINT = O_WD1 + 2 * E_WD, O_WINN = O_WINT + 2 * E_WINT, O_WM = O_WINN + 2 * E_WINN,
                 O_WOUT = O_WM + 2 * E_WM, O_WQ = O_WOUT + 2 * E_SQ, O_WK = O_WQ + 2 * E_SQ, O_WV = O_WK + 2 * E_SQ, O_WO = O_WV + 2 * E_SQ,
                 O_WGU2 = O_WO + 2 * E_SQ, O_WD2 = O_WGU2 + 2 * E_WGU, O_WEND = O_WD2 + 2 * E_WD;
constexpr size_t O_XB = O_WEND, O_DFTM = O_XB + (size_t)NTOK * DM * 2, O_MB = O_DFTM + (size_t)4096 * 8192 * 2, O_KB = O_MB + (size_t)MEMROWS * DM * 2,
                 O_VT = O_KB + (size_t)MEMROWS * DM * 2, O_HID = O_VT + (size_t)MEMROWS * DM * 2, O_PART = O_HID + (size_t)4096 * 64 * 4,
                 O_RSTD = O_PART + (size_t)NTOK * 32 * 4, O_RSTDM = O_RSTD + (size_t)NTOK * 4, O_BAR = O_RSTDM + 4096, O_ARENA = O_BAR + 16384;
constexpr size_t A_HTFT = O_ARENA, A_PN = A_HTFT + (size_t)4096 * NTOK * 2, A_ZCAT = A_PN + (size_t)NTOK * 6656 * 2, A_MB16 = A_ZCAT + (size_t)NTOK * 2560 * 2,
                 A_HST = A_MB16 + (size_t)NTOK * DM * 2, A_Z2T = A_HST + (size_t)256 * 131072, O_XB8 = A_Z2T + (size_t)1024 * NTOK * 2, O_W4T = O_XB8 + (size_t)NTOK * DM, O_HIDB = O_W4T + (size_t)4096 * 256 * 2, A_END = O_HIDB + (size_t)4096 * 256 * 2;
constexpr size_t A_H = O_ARENA, A_Y = A_PN + (size_t)NTOK * 2560 * 2  , A_MF = A_HTFT, A_Q = O_ARENA, A_P = A_Q + (size_t)NTOK * DM * 2,
                 A_O = A_P + (size_t)NTOK * 1024 * 2;
static_assert(A_Y + (size_t)NTOK * DM * 4 <= A_ZCAT, "y must fit in PN tail");
static_assert(A_O + (size_t)NTOK * DM * 2 <= A_Y, "attention buffers below y");
static_assert(A_H + (size_t)NTOK * DFF * 2 <= A_Y, "H below y");

struct Params {
  const float* in[NIN];
  float* out;
  unsigned char* ws;
  int lsz[NIN];
  int pad;
};

typedef const __attribute__((address_space(4))) Params* KP;
constexpr int WTAB_OFF = LDS_BYTES - 16 - 256;
extern __shared__ __attribute__((aligned(16))) unsigned char g_lds[];
__device__ __forceinline__ int TIDX() {
  int lane; asm volatile("v_mbcnt_lo_u32_b32 %0, -1, 0\n\tv_mbcnt_hi_u32_b32 %0, -1, %0" : "=v"(lane));
  const unsigned hw = (unsigned)__builtin_amdgcn_s_getreg(((6 - 1) << 11) | 4) & 63u;
  const int wave = *(volatile LAS int*)((LAS unsigned char*)g_lds + WTAB_OFF + hw * 4);
  return wave * 64 + lane;
}
__device__ __forceinline__ int BIDX() { int b = __builtin_amdgcn_workgroup_id_x(); asm volatile("" : "+s"(b)); return b; }
__device__ __forceinline__ int GDIM() { int g = (int)__ockl_get_num_groups(0); asm volatile("" : "+s"(g)); return g; }
__device__ __forceinline__ unsigned cvt_pk_bf16(float lo, float hi) { unsigned r; asm("v_cvt_pk_bf16_f32 %0, %1, %2" : "=v"(r) : "v"(lo), "v"(hi)); return r; }
__device__ __forceinline__ unsigned cvt4_fp8(float a, float b, float c, float d) { int w = 0; w = __builtin_amdgcn_cvt_pk_fp8_f32(a, b, w, false); w = __builtin_amdgcn_cvt_pk_fp8_f32(c, d, w, true); return (unsigned)w; }
__device__ __forceinline__ float bf2f(unsigned b) { return __uint_as_float(b << 16); }
__device__ __forceinline__ bf16_t f2bf(float f) { return (bf16_t)(cvt_pk_bf16(f, 0.f) & 0xffffu); }
__device__ __forceinline__ float shfl_xor_f(float v, int m) { const int lane = TIDX() & 63; return __int_as_float(__builtin_amdgcn_ds_bpermute((lane ^ m) << 2, __float_as_int(v))); }
__device__ __forceinline__ float wave_sum(float v) {
  v += __int_as_float(__builtin_amdgcn_ds_swizzle(__float_as_int(v), (16 << 10) | 0x1F));
  v += __int_as_float(__builtin_amdgcn_ds_swizzle(__float_as_int(v), (8 << 10) | 0x1F));
  v += __int_as_float(__builtin_amdgcn_ds_swizzle(__float_as_int(v), (4 << 10) | 0x1F));
  v += __int_as_float(__builtin_amdgcn_ds_swizzle(__float_as_int(v), (2 << 10) | 0x1F));
  v += __int_as_float(__builtin_amdgcn_ds_swizzle(__float_as_int(v), (1 << 10) | 0x1F));
  return __int_as_float(__builtin_amdgcn_readlane(__float_as_int(v), 0)) + __int_as_float(__builtin_amdgcn_readlane(__float_as_int(v), 32));
}

namespace pg8 {
constexpr int BM = 256, BK = 64, HALF = 128, HTB = HALF * BK * 2, STAGE_BYTES = 8 * HTB, NXCD = 8, WGM = 8;
__device__ __forceinline__ int lds_byte(int r, int c) { const int st = (r >> 4) * 2 + (c >> 5), rr = r & 15, cc = c & 31, ob = rr * 64 + cc * 2; return st * 1024 + (ob ^ (((ob >> 9) & 1) << 5)); }
__device__ __forceinline__ void stage_rc(int b, int& R, int& C) { const int st = b / 1024, sb = b % 1024, swz = sb ^ (((sb >> 9) & 1) << 5); R = (st >> 1) * 16 + swz / 64; C = (st & 1) * 32 + (swz % 64) / 2; }
__device__ __forceinline__ int perm32(int rho) { const int n = rho >> 4, i = rho & 15; return 8 * (i >> 2) + 4 * n + (i & 3); }

struct Unit { const char* a; const char* b; int pm, pn; };

struct Sched {
  int mode; const char* A; const char* B; int lda, ldb, nM, nN, nwg, G, c, koff;
  __device__ __forceinline__ void init(int mode_, const void* A_, const void* B_, int lda_, int ldb_, int M, int N, int koff_) {
    mode = mode_; A = (const char*)A_; B = (const char*)B_; lda = lda_; ldb = ldb_; nM = M / BM; nN = N / BM; nwg = nM * nN; G = (int)GDIM(); c = (int)BIDX(); koff = koff_;
  }
  __device__ __forceinline__ bool next(int i, Unit& u) const {
    const long Lq = (long)i * G + c; if (Lq >= nwg) return false;
    int wgid = (int)Lq;
    if (mode == 0) {
      { const int q = nwg / NXCD, r = nwg % NXCD, xcd = wgid % NXCD, off = wgid / NXCD; wgid = (xcd < r ? xcd * (q + 1) : r * (q + 1) + (xcd - r) * q) + off; }
      const int nig = WGM * nN, gid = wgid / nig, fm = gid * WGM, gsz = (nM - fm) < WGM ? (nM - fm) : WGM;
      u.pm = fm + ((wgid % nig) % gsz); u.pn = (wgid % nig) / gsz;
      u.a = A + ((size_t)u.pm * BM * lda + koff) * 2; u.b = B + ((size_t)u.pn * BM * ldb + koff) * 2;
    } else if (mode == 1) {
      const int b = wgid >> 6, h = (wgid >> 4) & 3, qt = wgid & 15;
      u.pm = b * 16 + qt; u.pn = h;
      u.a = A + ((size_t)(b * 4096 + qt * 256) * 2048 + h * 512) * 2; u.b = B + ((size_t)(b * 256) * 2048 + h * 512) * 2;
    } else if (mode == 2) {
      const int dt = wgid & 1, qt = (wgid >> 1) & 15, h = (wgid >> 5) & 3, b = wgid >> 7;
      u.pm = b * 16 + qt; u.pn = h * 2 + dt;
      u.a = A + ((size_t)(b * 4096 + qt * 256) * 1024 + h * 256) * 2; u.b = B + ((size_t)(h * 512 + dt * 256) * 1024 + b * 256) * 2;
    } else {
      const int x = wgid & 7, j = wgid >> 3, b = x >> 1, s = x & 1, kt = j >> 1, mt = j & 1;
      u.pm = b * 16 + kt; u.pn = 4 + s * 2 + mt;
      u.a = A + ((size_t)(kt * 256) * 8192 + s * 4096) * 2; u.b = B + ((size_t)(b * 512 + mt * 256) * 8192 + s * 4096) * 2;
    }
    return true;
  }
};

typedef int i32x4v __attribute__((ext_vector_type(4)));
typedef int i32x8v __attribute__((ext_vector_type(8)));
template <class Epi, bool F8 = false>
__device__ __forceinline__ void gemm_phase(LAS unsigned char* lds, const Sched& S, int nt, const Epi& E) {
    int tid = TIDX(); asm volatile("" : "+v"(tid));
    const int wid = __builtin_amdgcn_readfirstlane(tid >> 6), lane = tid & 63, wr = wid >> 2, wc = wid & 3, fr = lane & 15, fq = lane >> 4;
    unsigned voffA[1], voffB[1];
    { int R, C; stage_rc(tid * 16, R, C); const int Rb = Epi::PERM ? ((R & ~31) + perm32(R & 31)) : R;
        voffA[0] = (unsigned)(R * S.lda + C) * 2u; voffB[0] = (unsigned)(Rb * S.ldb + C) * 2u; }
    const size_t qstepA = (size_t)64 * S.lda * 2, qstepB = (size_t)64 * S.ldb * 2;
    const size_t kstep = (size_t)(BK * 2);
    const size_t hstepA = (size_t)HALF * S.lda * 2, hstepB = (size_t)HALF * S.ldb * 2;
    const unsigned ldsw = (unsigned)wid * 1024u;
    const int aoff = lds_byte(wr * 64 + fr, fq * 8), boff = lds_byte(wc * 32 + fr, fq * 8);
#define PG8_SA(b, h) (((b) * 2 + (h)) * HTB)
#define PG8_SB(b, h) ((4 + (b) * 2 + (h)) * HTB)
#define PG8_STAGE(bufoff, gbase, voff) do { _Pragma("unroll") for (int _i = 0; _i < 2; ++_i) \
        __builtin_amdgcn_global_load_lds((const unsigned*)((const char*)(gbase) + (size_t)_i * q##voff + (voff)[0]), (LAS unsigned*)(lds + (bufoff) + ldsw + _i * 8192), 16, 0, 0); } while (0)
#define qvoffA qstepA
#define qvoffB qstepB
#define PG8_LDA(dst, b, h) do { if constexpr (F8) { _Pragma("unroll") for (int m = 0; m < 4; ++m) dst##8[m] = __builtin_shufflevector(*(const LAS i32x4v*)(lds + PG8_SA(b, h) + aoff + m * 2048), *(const LAS i32x4v*)(lds + PG8_SA(b, h) + aoff + m * 2048 + 1024), 0, 1, 2, 3, 4, 5, 6, 7); } \
        else { _Pragma("unroll") for (int m = 0; m < 4; ++m) _Pragma("unroll") for (int k = 0; k < 2; ++k) dst[m][k] = *(const LAS bf16x8*)(lds + PG8_SA(b, h) + aoff + m * 2048 + k * 1024); } } while (0)
#define PG8_LDB(dst, b, h) do { if constexpr (F8) { _Pragma("unroll") for (int n = 0; n < 2; ++n) dst##8[n] = __builtin_shufflevector(*(const LAS i32x4v*)(lds + PG8_SB(b, h) + boff + n * 2048), *(const LAS i32x4v*)(lds + PG8_SB(b, h) + boff + n * 2048 + 1024), 0, 1, 2, 3, 4, 5, 6, 7); } \
        else { _Pragma("unroll") for (int n = 0; n < 2; ++n) _Pragma("unroll") for (int k = 0; k < 2; ++k) dst[n][k] = *(const LAS bf16x8*)(lds + PG8_SB(b, h) + boff + n * 2048 + k * 1024); } } while (0)
#define PG8_MMA(ai, bj, At, Bt) do { __builtin_amdgcn_s_setprio(1); \
        if constexpr (F8) { _Pragma("unroll") for (int m = 0; m < 4; ++m) _Pragma("unroll") for (int n = 0; n < 2; ++n) \
            asm volatile("v_mfma_scale_f32_16x16x128_f8f6f4 %0, %1, %2, %0, %3, %3 op_sel_hi:[0,0,0]" : "+v"(acc[ai][bj][m][n]) : "v"(Bt##8[n]), "v"(At##8[m]), "v"(f8scale)); } \
        else { _Pragma("unroll") for (int m = 0; m < 4; ++m) _Pragma("unroll") for (int n = 0; n < 2; ++n) _Pragma("unroll") for (int k = 0; k < 2; ++k) \
            acc[ai][bj][m][n] = __builtin_amdgcn_mfma_f32_16x16x32_bf16(Bt[n][k], At[m][k], acc[ai][bj][m][n], 0, 0, 0); } \
        __builtin_amdgcn_s_setprio(0); } while (0)
#define PG8_WAIT_V(n) asm volatile("s_waitcnt vmcnt(" #n ")" ::: "memory")
#define PG8_WAIT_L(n) asm volatile("s_waitcnt lgkmcnt(" #n ")" ::: "memory")
#define PG8_BAR __builtin_amdgcn_s_barrier()
#define PG8_SCHED __builtin_amdgcn_sched_barrier(0)
    Unit cur, nxt; int ui = 0;
    if (!S.next(0, cur)) return;
    f32x4 acc[2][2][4][2];
#pragma unroll
    for (int a = 0; a < 2; ++a)
#pragma unroll
        for (int b = 0; b < 2; ++b)
#pragma unroll
            for (int m = 0; m < 4; ++m)
#pragma unroll
                for (int n = 0; n < 2; ++n) acc[a][b][m][n] = (f32x4){0.f, 0.f, 0.f, 0.f};
    bf16x8 At[4][2], B0[2][2], B1[2][2]; i32x8v At8[4], B08[2], B18[2]; const int f8scale = 0x7f7f7f7f;
    const char* cA = cur.a; const char* cB = cur.b;
    PG8_STAGE(PG8_SB(0, 0), cB, voffB); PG8_STAGE(PG8_SA(0, 0), cA, voffA); PG8_STAGE(PG8_SB(0, 1), cB + hstepB, voffB); PG8_STAGE(PG8_SA(0, 1), cA + hstepA, voffA);
    if (wr == 1) PG8_BAR;
    PG8_WAIT_V(4); PG8_BAR;
    PG8_STAGE(PG8_SB(1, 0), cB + kstep, voffB); PG8_STAGE(PG8_SA(1, 0), cA + kstep, voffA); PG8_STAGE(PG8_SB(1, 1), cB + hstepB + kstep, voffB);
    PG8_WAIT_V(6); PG8_BAR;
    for (;;) {
        const bool has_next = S.next(ui + 1, nxt);
        const char* nA = has_next ? nxt.a : cA; const char* nB = has_next ? nxt.b : cB;
        for (int t = 0; t < nt; t += 2) {
            const bool last = (t == nt - 2);
            const char* a1 = cA + (size_t)(t + 1) * kstep;
            const char* a2 = last ? nA : cA + (size_t)(t + 2) * kstep; const char* b2 = last ? nB : cB + (size_t)(t + 2) * kstep;
            const char* a3 = a2 + kstep; const char* b3 = b2 + kstep;
            PG8_LDB(B0, 0, 0); PG8_SCHED; PG8_LDA(At, 0, 0); PG8_STAGE(PG8_SA(1, 1), a1 + hstepA, voffA);
            PG8_WAIT_L(8); PG8_BAR; PG8_WAIT_L(0); PG8_MMA(0, 0, At, B0); PG8_BAR; PG8_SCHED;
            PG8_LDB(B1, 0, 1); PG8_STAGE(PG8_SB(0, 0), b2, voffB);
            PG8_BAR; PG8_WAIT_L(0); PG8_MMA(0, 1, At, B1); PG8_BAR;
            PG8_LDA(At, 0, 1); PG8_STAGE(PG8_SA(0, 0), a2, voffA);
            PG8_BAR; PG8_WAIT_L(0); PG8_MMA(1, 0, At, B0); PG8_BAR; PG8_SCHED;
            PG8_STAGE(PG8_SB(0, 1), b2 + hstepB, voffB);
            PG8_WAIT_V(6); PG8_BAR; PG8_MMA(1, 1, At, B1); PG8_BAR;
            PG8_LDB(B0, 1, 0); PG8_SCHED; PG8_LDA(At, 1, 0); PG8_STAGE(PG8_SA(0, 1), a2 + hstepA, voffA);
            PG8_WAIT_L(8); PG8_BAR; PG8_WAIT_L(0); PG8_MMA(0, 0, At, B0); PG8_BAR; PG8_SCHED;
            PG8_LDB(B1, 1, 1); PG8_STAGE(PG8_SB(1, 0), b3, voffB);
            PG8_BAR; PG8_WAIT_L(0); PG8_MMA(0, 1, At, B1); PG8_BAR;
            PG8_LDA(At, 1, 1); PG8_STAGE(PG8_SA(1, 0), a3, voffA);
            PG8_BAR; PG8_WAIT_L(0); PG8_MMA(1, 0, At, B0); PG8_BAR; PG8_SCHED;
            PG8_STAGE(PG8_SB(1, 1), b3 + hstepB, voffB);
            PG8_WAIT_V(6); PG8_BAR; PG8_MMA(1, 1, At, B1); PG8_BAR;
        }
        if constexpr (F8) { asm volatile("s_nop 15\n\ts_nop 15\n\ts_nop 15\n\ts_nop 15" ::: "memory"); }
        if constexpr (!Epi::AFTER_DRAIN) { E(acc, cur, wr, wc, fr, fq); }
        if (!has_next) break;
#pragma unroll
        for (int a = 0; a < 2; ++a)
#pragma unroll
            for (int b = 0; b < 2; ++b)
#pragma unroll
                for (int m = 0; m < 4; ++m)
#pragma unroll
                    for (int n = 0; n < 2; ++n) acc[a][b][m][n] = (f32x4){0.f, 0.f, 0.f, 0.f};
        cur = nxt; cA = nA; cB = nB; ++ui;
    }
    PG8_WAIT_V(0);
    if (wr == 0) PG8_BAR;
    PG8_BAR;
    if constexpr (Epi::AFTER_DRAIN) { E.fused(acc, cur, wr, wc, fr, fq, lds, wid, lane); }
#undef PG8_SA
#undef PG8_SB
#undef PG8_STAGE
#undef qvoffA
#undef qvoffB
#undef PG8_LDA
#undef PG8_LDB
#undef PG8_MMA
#undef PG8_WAIT_V
#undef PG8_WAIT_L
#undef PG8_BAR
#undef PG8_SCHED
}

typedef f32x4 Acc[2][2][4][2];

struct EpiSwiGLU {
  static constexpr bool PERM = true, AFTER_DRAIN = false;
  bf16_t* H; const float* rs; float cscale; int h8;
  __device__ __forceinline__ void operator()(const Acc& acc, const Unit& u, int wr_, int wc_, int fr_, int fq_) const {
    const int tid_ = TIDX(), lane_ = tid_ & 63, wid_ = tid_ >> 6, wr = wid_ >> 2, wc = wid_ & 3, fr = lane_ & 15, fq = lane_ >> 4;
    const int row0 = u.pm * BM + wr * 64 + fr, col0 = u.pn * 128 + wc * 32 + 8 * fq;
#pragma unroll
    for (int ai = 0; ai < 2; ++ai)
#pragma unroll
      for (int m = 0; m < 4; ++m) {
        const int row = row0 + ai * HALF + m * 16; const float r = rs ? rs[row] : cscale;
        float o[8];
#pragma unroll
        for (int n = 0; n < 2; ++n)
#pragma unroll
          for (int j = 0; j < 4; ++j) { const float g = acc[ai][0][m][n][j] * r, up = acc[ai][1][m][n][j] * r; o[n * 4 + j] = g * up * __builtin_amdgcn_rcpf(1.0f + __builtin_amdgcn_exp2f(g * -1.4426950408889634f)); }
        if (h8) { u32x2 w; w.x = cvt4_fp8(o[0] * F8_SH, o[1] * F8_SH, o[2] * F8_SH, o[3] * F8_SH); w.y = cvt4_fp8(o[4] * F8_SH, o[5] * F8_SH, o[6] * F8_SH, o[7] * F8_SH); *(u32x2*)((unsigned char*)H + (size_t)row * DFF + col0) = w; }
        else { u32x4 w; w.x = cvt_pk_bf16(o[0], o[1]); w.y = cvt_pk_bf16(o[2], o[3]); w.z = cvt_pk_bf16(o[4], o[5]); w.w = cvt_pk_bf16(o[6], o[7]);
        *(u32x4*)(H + (size_t)row * DFF + col0) = w; }
      }
  }
};
struct EpiY {
  static constexpr bool PERM = true, AFTER_DRAIN = false;
  bf16_t* Y; float* part; float cs;
  __device__ __forceinline__ void operator()(const Acc& acc, const Unit& u, int wr, int wc, int fr, int fq) const {
    const int row0 = u.pm * BM + wr * 64 + fr, col0 = u.pn * BM + wc * 32 + 8 * fq;
#pragma unroll
    for (int ai = 0; ai < 2; ++ai)
#pragma unroll
      for (int m = 0; m < 4; ++m) {
        const int row = row0 + ai * HALF + m * 16; bf16_t* rowp = Y + (size_t)row * DM + col0; float s = 0.f;
#pragma unroll
        for (int bj = 0; bj < 2; ++bj) {
          const f32x4 v0 = acc[ai][bj][m][0] * cs, v1 = acc[ai][bj][m][1] * cs;
          s += (v0[0] * v0[0] + v0[1] * v0[1]) + (v0[2] * v0[2] + v0[3] * v0[3]) + (v1[0] * v1[0] + v1[1] * v1[1]) + (v1[2] * v1[2] + v1[3] * v1[3]);
          u32x4 w; w.x = cvt_pk_bf16(v0[0], v0[1]); w.y = cvt_pk_bf16(v0[2], v0[3]); w.z = cvt_pk_bf16(v1[0], v1[1]); w.w = cvt_pk_bf16(v1[2], v1[3]);
          *(u32x4*)(rowp + bj * HALF) = w;
        }
        s += shfl_xor_f(s, 16); s += shfl_xor_f(s, 32);
        if (fq == 0) part[(size_t)row * 32 + u.pn * 4 + wc] = s;
      }
  }
};
struct EpiRowBf16 {
  static constexpr bool PERM = true, AFTER_DRAIN = false;
  bf16_t* O; int ldc; const float* rs; int act, actcol0;
  __device__ __forceinline__ void operator()(const Acc& acc, const Unit& u, int wr, int wc, int fr, int fq) const {
    const int row0 = u.pm * BM + wr * 64 + fr, col0 = u.pn * BM + wc * 32 + 8 * fq;
    const bool sg = act && (u.pn * BM >= actcol0);
#pragma unroll
    for (int ai = 0; ai < 2; ++ai)
#pragma unroll
      for (int m = 0; m < 4; ++m) {
        const int row = row0 + ai * HALF + m * 16; const float r = rs ? rs[row] : 1.0f; bf16_t* rowp = O + (size_t)row * ldc + col0;
#pragma unroll
        for (int bj = 0; bj < 2; ++bj) {
          f32x4 v0 = acc[ai][bj][m][0] * r, v1 = acc[ai][bj][m][1] * r;
          if (sg) {
#pragma unroll
            for (int j = 0; j < 4; ++j) { v0[j] = __builtin_amdgcn_rcpf(1.0f + __builtin_amdgcn_exp2f(v0[j] * -1.4426950408889634f)); v1[j] = __builtin_amdgcn_rcpf(1.0f + __builtin_amdgcn_exp2f(v1[j] * -1.4426950408889634f)); }
          }
          u32x4 w; w.x = cvt_pk_bf16(v0[0], v0[1]); w.y = cvt_pk_bf16(v0[2], v0[3]); w.z = cvt_pk_bf16(v1[0], v1[1]); w.w = cvt_pk_bf16(v1[2], v1[3]);
          *(u32x4*)(rowp + bj * HALF) = w;
        }
      }
  }
};
struct EpiColBf16 {
  static constexpr bool PERM = true, AFTER_DRAIN = false;
  bf16_t* O; const float* cs; int mode;
  __device__ __forceinline__ void operator()(const Acc& acc, const Unit& u, int wr, int wc, int fr, int fq) const {
    const int row0 = u.pm * BM + wr * 64 + fr, col0 = u.pn * BM + wc * 32 + 8 * fq;
    f32x4 sc[2][2];
#pragma unroll
    for (int bj = 0; bj < 2; ++bj)
#pragma unroll
      for (int n = 0; n < 2; ++n) sc[bj][n] = *(const f32x4*)(cs + col0 + bj * HALF + 4 * n);
#pragma unroll
    for (int ai = 0; ai < 2; ++ai)
#pragma unroll
      for (int m = 0; m < 4; ++m) {
        const int row = row0 + ai * HALF + m * 16;
#pragma unroll
        for (int bj = 0; bj < 2; ++bj) {
          const int col = col0 + bj * HALF;
          size_t off;
          if (mode == 0) off = (size_t)row * 1024 + col;
          else if (row < 3072) off = (size_t)row * NTOK + col;
          else { const int rr = row - 3072, s = rr >> 9, mm = rr & 511, b = col >> 12, l = col & 4095; off = (size_t)3072 * NTOK + ((size_t)((b * 512 + mm) * 2 + s)) * 4096 + l; }
          const f32x4 v0 = acc[ai][bj][m][0] * sc[bj][0], v1 = acc[ai][bj][m][1] * sc[bj][1];
          u32x4 w; w.x = cvt_pk_bf16(v0[0], v0[1]); w.y = cvt_pk_bf16(v0[2], v0[3]); w.z = cvt_pk_bf16(v1[0], v1[1]); w.w = cvt_pk_bf16(v1[2], v1[3]);
          *(u32x4*)(O + off) = w;
        }
      }
  }
};
struct EpiFilt {
  static constexpr bool PERM = false, AFTER_DRAIN = false;
  float* TS;
  __device__ __forceinline__ void operator()(const Acc& acc, const Unit& u, int wr, int wc, int fr, int fq) const {
    const int row0 = u.pm * BM + wr * 64 + fr, col0 = u.pn * BM + wc * 32 + 4 * fq;
    const float min_decay = -3.0701134573f, max_decay = -15.3505672866f;
#pragma unroll
    for (int ai = 0; ai < 2; ++ai)
#pragma unroll
      for (int m = 0; m < 4; ++m) {
        const int row = row0 + ai * HALF + m * 16, ch = row & 1023, dir = (row >> 10) & 1, o = row >> 11;
        const float dl = fabsf(min_decay + (float)ch * ((max_decay - min_decay) / 1023.0f)) * (-1.4426950408889634f / (float)(SEQ - 1));
        float* dst = TS + (size_t)(o * 1024 + ch) * 8192;
#pragma unroll
        for (int bj = 0; bj < 2; ++bj)
#pragma unroll
          for (int n = 0; n < 2; ++n) {
            const int pos = col0 + bj * HALF + n * 16; f32x4 v;
#pragma unroll
            for (int j = 0; j < 4; ++j) v[j] = acc[ai][bj][m][n][j] * __builtin_amdgcn_exp2f((float)(pos + j) * dl) * (1.0f / 8192.0f);
            if (dir == 0) *(f32x4*)(dst + pos) = v;
            else if (pos != 0) { const f32x4 r = {v[3], v[2], v[1], v[0]}; *(f32x4*)(dst + 8192 - pos - 3) = r; }
            else { dst[4096] = 0.f; dst[8191] = v[1]; dst[8190] = v[2]; dst[8189] = v[3]; }
          }
      }
  }
};
template <int W> struct EpiMerge {
  static constexpr bool PERM = false, AFTER_DRAIN = false;
  float* MF; bf16_t* MB; const bf16_t* PN;
  __device__ __forceinline__ void operator()(const Acc& acc, const Unit& u, int wr, int wc, int fr, int fq) const {
    const int row0 = u.pm * BM + wr * 64 + fr, col0 = u.pn * BM + wc * 32 + 4 * fq;
#pragma unroll
    for (int ai = 0; ai < 2; ++ai)
#pragma unroll
      for (int m = 0; m < 4; ++m) {
        const int row = row0 + ai * HALF + m * 16;
#pragma unroll
        for (int bj = 0; bj < 2; ++bj)
#pragma unroll
          for (int n = 0; n < 2; ++n) {
            const int col = col0 + bj * HALF + n * 16;
            const u32x2 gw = *(const u32x2*)(PN + (size_t)row * 6656 + 512 + W * 2048 + col);
            f32x4 g; g[0] = bf2f(gw.x & 0xffffu); g[1] = bf2f(gw.x >> 16); g[2] = bf2f(gw.y & 0xffffu); g[3] = bf2f(gw.y >> 16);
            f32x4 v = acc[ai][bj][m][n] * g;
            float* mp = MF + (size_t)row * DM + col;
            if (W > 0) v += *(const f32x4*)mp;
            if (W < 2) *(f32x4*)mp = v;
            else { u32x2 w; w.x = cvt_pk_bf16(v[0], v[1]); w.y = cvt_pk_bf16(v[2], v[3]); *(u32x2*)(MB + (size_t)row * DM + col) = w; }
          }
      }
  }
};
struct EpiSoftmax {
  static constexpr bool PERM = true, AFTER_DRAIN = true;
  bf16_t* P; float scale_log2e;
  __device__ __forceinline__ void fused(Acc& acc, const Unit& u, int wr, int wc, int fr, int fq, LAS unsigned char* lds, int wid, int lane) const {
    LAS float* RM = (LAS float*)lds;
    LAS float* RS = (LAS float*)(lds + 4096);
    float mx[2][4];
#pragma unroll
    for (int ai = 0; ai < 2; ++ai)
#pragma unroll
      for (int m = 0; m < 4; ++m) {
        float v = -3.0e38f;
#pragma unroll
        for (int bj = 0; bj < 2; ++bj)
#pragma unroll
          for (int n = 0; n < 2; ++n)
#pragma unroll
            for (int j = 0; j < 4; ++j) v = fmaxf(v, acc[ai][bj][m][n][j]);
        v = fmaxf(v, shfl_xor_f(v, 16)); v = fmaxf(v, shfl_xor_f(v, 32));
        if (fq == 0) RM[(ai * HALF + wr * 64 + m * 16 + fr) * 4 + wc] = v;
      }
    __syncthreads();
#pragma unroll
    for (int ai = 0; ai < 2; ++ai)
#pragma unroll
      for (int m = 0; m < 4; ++m) {
        const int r = ai * HALF + wr * 64 + m * 16 + fr;
        const f32x4 q = *(const LAS f32x4*)(RM + r * 4);
        const float mxx = fmaxf(fmaxf(q[0], q[1]), fmaxf(q[2], q[3]));
        float s = 0.f;
#pragma unroll
        for (int bj = 0; bj < 2; ++bj)
#pragma unroll
          for (int n = 0; n < 2; ++n)
#pragma unroll
            for (int j = 0; j < 4; ++j) { const float e = __builtin_amdgcn_exp2f((acc[ai][bj][m][n][j] - mxx) * scale_log2e); acc[ai][bj][m][n][j] = e; s += e; }
        s += shfl_xor_f(s, 16); s += shfl_xor_f(s, 32);
        if (fq == 0) RS[r * 4 + wc] = s;
        mx[ai][m] = 0.f;
      }
    __syncthreads();
    const int row0 = u.pm * BM + wr * 64 + fr, col0 = u.pn * BM + wc * 32 + 8 * fq;
#pragma unroll
    for (int ai = 0; ai < 2; ++ai)
#pragma unroll
      for (int m = 0; m < 4; ++m) {
        const int r = ai * HALF + wr * 64 + m * 16 + fr;
        const f32x4 q = *(const LAS f32x4*)(RS + r * 4);
        const float inv = 1.0f / ((q[0] + q[1]) + (q[2] + q[3]) + mx[ai][m]);
        bf16_t* rowp = P + (size_t)(row0 + ai * HALF + m * 16) * 1024 + col0;
#pragma unroll
        for (int bj = 0; bj < 2; ++bj) {
          const f32x4 v0 = acc[ai][bj][m][0] * inv, v1 = acc[ai][bj][m][1] * inv;
          u32x4 w; w.x = cvt_pk_bf16(v0[0], v0[1]); w.y = cvt_pk_bf16(v0[2], v0[3]); w.z = cvt_pk_bf16(v1[0], v1[1]); w.w = cvt_pk_bf16(v1[2], v1[3]);
          *(u32x4*)(rowp + bj * HALF) = w;
        }
      }
    __syncthreads();
  }
};
}

__device__ __forceinline__ const float* inl(KP p, int i, int l) { return p->in[i] + (size_t)l * p->lsz[i]; }

struct CJob { const float* src; const float* gain; bf16_t* dst; int K, N, lds_, ldd, koff, col0, mode, f8; };
__device__ __forceinline__ bool get_job(KP p, int l, int j, CJob& J) {
  bf16_t* wb = (bf16_t*)p->ws;
  J.gain = nullptr; J.koff = 0; J.col0 = 0; J.mode = 0; J.f8 = 0;
  switch (j) {
    case 0: J.src = inl(p, 3, l); J.gain = inl(p, 2, l); J.dst = wb + O_WGU1 / 2; J.K = 2048; J.N = 11264; J.lds_ = 11264; J.ldd = 2048; J.mode = 1; J.f8 = (l == 1); break;
    case 1: J.src = inl(p, 4, l); J.dst = wb + O_WD1 / 2; J.K = 5632; J.N = 2048; J.lds_ = 2048; J.ldd = 5632; break;
    case 2: J.src = inl(p, 7, l); J.gain = inl(p, 6, l); J.dst = wb + O_WINT / 2; J.K = 2048; J.N = 3072; J.lds_ = 10240; J.ldd = 2048; break;
    case 3: J.src = inl(p, 7, l); J.gain = inl(p, 6, l); J.dst = wb + O_WINN / 2; J.K = 2048; J.N = 6656; J.lds_ = 10240; J.ldd = 2048; J.col0 = 3584; break;
    case 4: J.src = inl(p, 19, l); J.dst = wb + O_WM / 2; J.K = 1024; J.N = 2048; J.lds_ = 2048; J.ldd = 2560; break;
    case 5: J.src = inl(p, 20, l); J.dst = wb + O_WM / 2; J.K = 512; J.N = 2048; J.lds_ = 2048; J.ldd = 2560; J.koff = 1024; break;
    case 6: J.src = inl(p, 20, l); J.dst = wb + O_WM / 2; J.K = 512; J.N = 2048; J.lds_ = 2048; J.ldd = 2560; J.koff = 1536; break;
    case 7: J.src = inl(p, 23, l); J.dst = wb + O_WOUT / 2; J.K = 2048; J.N = 2048; J.lds_ = 2048; J.ldd = 2048; break;
    case 8: J.src = inl(p, 27, l); J.gain = inl(p, 25, l); J.dst = wb + O_WQ / 2; J.K = 2048; J.N = 2048; J.lds_ = 2048; J.ldd = 2048; break;
    case 9: J.src = inl(p, 28, l); J.gain = inl(p, 26, l); J.dst = wb + O_WK / 2; J.K = 2048; J.N = 2048; J.lds_ = 4096; J.ldd = 2048; break;
    case 10: J.src = inl(p, 28, l); J.gain = inl(p, 26, l); J.dst = wb + O_WV / 2; J.K = 2048; J.N = 2048; J.lds_ = 4096; J.ldd = 2048; J.col0 = 2048; break;
    case 11: J.src = inl(p, 29, l); J.dst = wb + O_WO / 2; J.K = 2048; J.N = 2048; J.lds_ = 2048; J.ldd = 2048; break;
    case 12: J.src = inl(p, 32, l); J.gain = inl(p, 31, l); J.dst = wb + O_WGU2 / 2; J.K = 2048; J.N = 11264; J.lds_ = 11264; J.ldd = 2048; J.mode = 1; J.f8 = (l == 1); break;
    case 13: J.src = inl(p, 33, l); J.dst = wb + O_WD2 / 2; J.K = 5632; J.N = 2048; J.lds_ = 2048; J.ldd = 5632; J.f8 = (l == 1); break;
    case 14: J.src = inl(p, 16, l); J.dst = (bf16_t*)(p->ws + O_W4T); J.K = 64; J.N = 4096; J.lds_ = 4096; J.ldd = 256; break;
    default: return false;
  }
  return true;
}

__device__ __forceinline__ void phase_conv(KP p, int l, float* ldsf) {
  const int tid = TIDX();
  {
    int buf = 0;
    const int r = tid >> 5, c4 = (tid & 31) * 4;
    float* gl = ldsf + 2 * 64 * 132;
    for (int j = 0; j < 15; ++j) {
      CJob J; get_job(p, l, j, J);
      const int nkt = J.K / 64, ntile = nkt * (J.N / 128);
      const float gsc = J.f8 ? F8_SW : 1.0f;
      __syncthreads();
      for (int e = tid; e < J.K; e += 512) gl[e] = (J.gain ? J.gain[e] : 1.0f) * gsc;
      asm volatile("s_waitcnt vmcnt(0)" ::: "memory");
      __syncthreads();
      auto load_tile = [&](f32x4 (&v)[4], int t) {
        const int kt = t % nkt, ntl = t / nkt, k0 = kt * 64, n0 = ntl * 128;
        int scol; if (J.mode == 1) { const int tt = n0 >> 8, h = (n0 >> 7) & 1; scol = h * DFF + tt * 128; } else scol = J.col0 + n0;
        const float* sp = J.src + (size_t)(k0 + r) * J.lds_ + scol + c4;
#pragma unroll
        for (int q = 0; q < 4; ++q) { const float* a = sp + (size_t)(16 * q) * J.lds_; asm volatile("global_load_dwordx4 %0, %1, off" : "=&v"(v[q]) : "v"(a) : "memory"); } };
      auto dummy_loads = [&](f32x4 (&v)[4]) {
#pragma unroll
        for (int q = 0; q < 4; ++q) { const float* a = J.src + c4; asm volatile("global_load_dwordx4 %0, %1, off" : "=&v"(v[q]) : "v"(a) : "memory"); } };
      auto process_tile = [&](f32x4 (&v)[4], int t) {
        float* T = ldsf + buf * (64 * 132);
        const int kt = t % nkt, ntl = t / nkt, k0 = kt * 64, n0 = ntl * 128;
        asm volatile("s_waitcnt vmcnt(4)" : "+v"(v[0]), "+v"(v[1]), "+v"(v[2]), "+v"(v[3]) :: "memory");
#pragma unroll
        for (int q = 0; q < 4; ++q) { const int row = r + 16 * q; const float g = gl[k0 + row]; *(f32x4*)(T + row * 132 + (c4 ^ (4 * ((row >> 3) & 7)))) = v[q] * g; }
        __syncthreads();
        if (J.f8) {
          const int n = tid >> 2, kc = (tid & 3) * 16;
          float o[16];
#pragma unroll
          for (int i = 0; i < 16; ++i) { const int row = kc + i; o[i] = T[row * 132 + ((n & ~3) ^ (4 * ((row >> 3) & 7))) + (n & 3)]; }
          u32x4 w; w.x = cvt4_fp8(o[0], o[1], o[2], o[3]); w.y = cvt4_fp8(o[4], o[5], o[6], o[7]); w.z = cvt4_fp8(o[8], o[9], o[10], o[11]); w.w = cvt4_fp8(o[12], o[13], o[14], o[15]);
          *(u32x4*)((unsigned char*)J.dst + (size_t)(n0 + n) * J.ldd + k0 + kc) = w;
        } else {
#pragma unroll
          for (int h = 0; h < 2; ++h) {
            const int id = tid + 512 * h, n = id >> 3, kc = (id & 7) * 8;
            float o[8];
#pragma unroll
            for (int i = 0; i < 8; ++i) { const int row = kc + i; o[i] = T[row * 132 + ((n & ~3) ^ (4 * ((row >> 3) & 7))) + (n & 3)]; }
            u32x4 w; w.x = cvt_pk_bf16(o[0], o[1]); w.y = cvt_pk_bf16(o[2], o[3]); w.z = cvt_pk_bf16(o[4], o[5]); w.w = cvt_pk_bf16(o[6], o[7]);
            *(u32x4*)(J.dst + (size_t)(n0 + n) * J.ldd + J.koff + k0 + kc) = w;
          }
        }
        buf ^= 1; };
      f32x4 va[4], vb[4];
      int t = BIDX();
      if (t < ntile) load_tile(va, t);
      while (t < ntile) {
        int tn = t + GDIM();
        if (tn < ntile) load_tile(vb, tn); else dummy_loads(vb);
        process_tile(va, t);
        t = tn; if (t >= ntile) break;
        tn = t + GDIM();
        if (tn < ntile) load_tile(va, tn); else dummy_loads(va);
        process_tile(vb, t);
        t = tn;
      }
      asm volatile("s_waitcnt vmcnt(0)" ::: "memory");
    }
    __syncthreads();
  }
  {
    const float* win = inl(p, 7, l); const float* gain = inl(p, 6, l); bf16_t* dst = (bf16_t*)p->ws + O_WINT / 2;
    float* tile = ldsf;
    float* ctab = ldsf + 64 * 129;
    if (tid < 128) { const float rv = (float)tid * (1.0f / 128.0f); ctab[tid] = __builtin_amdgcn_cosf(rv); ctab[128 + tid] = __builtin_amdgcn_sinf(rv); }
    const float scale = 0.0013810679f;
    for (int t = BIDX(); t < 256; t += GDIM()) {
      const int kt = t >> 3, g = (t >> 1) & 3, mh = t & 1, k0 = kt * 64;
      __syncthreads();
      for (int e = tid; e < 64 * 32; e += 512) { const int rr = e >> 5, c4 = (e & 31) * 4; const f32x4 v = *(const f32x4*)(win + (size_t)(k0 + rr) * 10240 + 3072 + g * 128 + c4);
        tile[rr * 129 + c4 + 0] = v[0]; tile[rr * 129 + c4 + 1] = v[1]; tile[rr * 129 + c4 + 2] = v[2]; tile[rr * 129 + c4 + 3] = v[3]; }
      __syncthreads();
      const int kk = tid & 63, mg = tid >> 6;
      float ac[8], as[8];
#pragma unroll
      for (int i = 0; i < 8; ++i) { ac[i] = 0.f; as[i] = 0.f; }
      for (int c = 0; c < 128; ++c) {
        const float x = tile[kk * 129 + c];
#pragma unroll
        for (int i = 0; i < 8; ++i) { const int m = mh * 64 + mg * 8 + i; const int ix = (m * c) & 127; ac[i] += x * ctab[ix]; as[i] += x * ctab[128 + ix]; }
      }
      const float gs = gain[k0 + kk] * scale;
#pragma unroll
      for (int i = 0; i < 8; ++i) { const int m = mh * 64 + mg * 8 + i;
        dst[(size_t)(3072 + g * 128 + m) * 2048 + k0 + kk] = f2bf(ac[i] * gs);
        dst[(size_t)(3072 + 512 + g * 128 + m) * 2048 + k0 + kk] = f2bf(as[i] * gs); }
    }
    __syncthreads();
  }
  {
    const float* wp = inl(p, 21, l); const float* ps = inl(p, 22, l); bf16_t* dst = (bf16_t*)p->ws + O_WM / 2;
    for (size_t e = (size_t)BIDX() * 512 + tid; e < (size_t)2048 * 512; e += (size_t)GDIM() * 512) {
      const int d = (int)(e >> 9), kk = (int)(e & 511), g = kk >> 7, c = kk & 127;
      float v = 0.f; if (g == (d >> 9)) v = wp[(size_t)(g * 128 + c) * 512 + (d & 511)] * ps[d];
      dst[(size_t)d * 2560 + 2048 + kk] = f2bf(v);
    }
    { bf16_t* w4t = (bf16_t*)(p->ws + O_W4T); bf16_t* hb = (bf16_t*)(p->ws + O_HIDB);
      for (size_t e = (size_t)BIDX() * 512 + tid; e < (size_t)4096 * 24; e += (size_t)GDIM() * 512) { const int n = (int)(e / 24), c8 = 64 + (int)(e % 24) * 8; const u32x4 z = {0u, 0u, 0u, 0u}; *(u32x4*)(w4t + (size_t)n * 256 + c8) = z; *(u32x4*)(hb + (size_t)n * 256 + c8) = z; } }
  }
}

__device__ __forceinline__ void phase_dftm(KP p, float* ldsf) {
  const int tid = TIDX();
  __syncthreads();
  for (int i = tid; i < 4096; i += 512) ldsf[i] = __builtin_amdgcn_cosf((float)i * (1.0f / 4096.0f));
  __syncthreads();
  bf16_t* D = (bf16_t*)(p->ws + O_DFTM);
  for (size_t e = (size_t)BIDX() * 512 + tid; e < (size_t)4096 * 1024; e += (size_t)GDIM() * 512) {
    const int k = (int)(e >> 10), j0 = (int)(e & 1023) * 8;
    float o[8];
#pragma unroll
    for (int i = 0; i < 8; ++i) { const int j = j0 + i;
      if (j < 4096) o[i] = ldsf[(k * j) & 4095]; else o[i] = -ldsf[((k * (j - 4096)) - 1024) & 4095]; }
    u32x4 w; w.x = cvt_pk_bf16(o[0], o[1]); w.y = cvt_pk_bf16(o[2], o[3]); w.z = cvt_pk_bf16(o[4], o[5]); w.w = cvt_pk_bf16(o[6], o[7]);
    *(u32x4*)(D + (size_t)k * 8192 + j0) = w;
  }
  __syncthreads();
}

__device__ __forceinline__ void phase_prep(KP p) {
  const int lane = TIDX() & 63, gw = (BIDX() * 512 + TIDX()) >> 6, nw = (GDIM() * 512) >> 6;
  for (int row = gw; row < NTOK + MEMROWS; row += nw) {
    const bool isx = row < NTOK; const int r = isx ? row : row - NTOK;
    const float* src = (isx ? p->in[0] : p->in[1]) + (size_t)r * DM;
    f32x4 v[8]; float ss = 0.f;
#pragma unroll
    for (int i = 0; i < 8; ++i) { v[i] = *(const f32x4*)(src + lane * 4 + i * 256); ss += (v[i][0] * v[i][0] + v[i][1] * v[i][1]) + (v[i][2] * v[i][2] + v[i][3] * v[i][3]); }
    ss = wave_sum(ss);
    const float rr = rsqrtf(ss * (1.0f / DM) + RMS_EPS);
    { bf16_t* dst = (bf16_t*)(p->ws + (isx ? O_XB : O_MB)) + (size_t)r * DM;
#pragma unroll
      for (int i = 0; i < 8; ++i) { u32x2 w; w.x = cvt_pk_bf16(v[i][0], v[i][1]); w.y = cvt_pk_bf16(v[i][2], v[i][3]); *(u32x2*)(dst + lane * 4 + i * 256) = w; }
    }
    if (lane == 0) ((float*)(p->ws + (isx ? O_RSTD : O_RSTDM)))[r] = rr;
  }
}

__device__ __forceinline__ void phase_resid(KP p, const float* xsrc, const float* gpost, float wgt, bool out8) {
  const int lane = TIDX() & 63, gw = (BIDX() * 512 + TIDX()) >> 6, nw = (GDIM() * 512) >> 6;
  const bf16_t* Y = (const bf16_t*)(p->ws + A_Y); const float* part = (const float*)(p->ws + O_PART);
  bf16_t* xb = (bf16_t*)(p->ws + O_XB); float* rstd = (float*)(p->ws + O_RSTD);
  for (int row0 = gw; row0 < NTOK; row0 += 2 * nw) {
    const int rowA = row0, rowB = row0 + nw;
    float psA = lane < 32 ? part[(size_t)rowA * 32 + lane] : 0.f, psB = lane < 32 ? part[(size_t)rowB * 32 + lane] : 0.f;
    u32x2 ya[8], yb[8]; f32x4 xa[8], xq[8];
#pragma unroll
    for (int i = 0; i < 8; ++i) { const int c = lane * 4 + i * 256; const size_t oa = (size_t)rowA * DM + c, ob = (size_t)rowB * DM + c;
      ya[i] = *(const u32x2*)(Y + oa); yb[i] = *(const u32x2*)(Y + ob); xa[i] = *(const f32x4*)(xsrc + oa); xq[i] = *(const f32x4*)(xsrc + ob); }
    psA = wave_sum(psA); psB = wave_sum(psB);
    const float rA = rsqrtf(psA * (1.0f / DM) + RMS_EPS) * wgt, rB = rsqrtf(psB * (1.0f / DM) + RMS_EPS) * wgt;
    float ssA = 0.f, ssB = 0.f;
#pragma unroll
    for (int i = 0; i < 8; ++i) { const int c = lane * 4 + i * 256; const f32x4 g = *(const f32x4*)(gpost + c);
      f32x4 y; y[0] = bf2f(ya[i].x & 0xffffu); y[1] = bf2f(ya[i].x >> 16); y[2] = bf2f(ya[i].y & 0xffffu); y[3] = bf2f(ya[i].y >> 16);
      xa[i] = xa[i] + y * g * rA; ssA += (xa[i][0] * xa[i][0] + xa[i][1] * xa[i][1]) + (xa[i][2] * xa[i][2] + xa[i][3] * xa[i][3]);
      y[0] = bf2f(yb[i].x & 0xffffu); y[1] = bf2f(yb[i].x >> 16); y[2] = bf2f(yb[i].y & 0xffffu); y[3] = bf2f(yb[i].y >> 16);
      xq[i] = xq[i] + y * g * rB; ssB += (xq[i][0] * xq[i][0] + xq[i][1] * xq[i][1]) + (xq[i][2] * xq[i][2] + xq[i][3] * xq[i][3]);
      *(f32x4*)(p->out + (size_t)rowA * DM + c) = xa[i]; *(f32x4*)(p->out + (size_t)rowB * DM + c) = xq[i]; }
    ssA = wave_sum(ssA); ssB = wave_sum(ssB);
    const float rrA = rsqrtf(ssA * (1.0f / DM) + RMS_EPS), rrB = rsqrtf(ssB * (1.0f / DM) + RMS_EPS);
    if (out8) {
      unsigned* dA = (unsigned*)(p->ws + O_XB8 + (size_t)rowA * DM); unsigned* dB = (unsigned*)(p->ws + O_XB8 + (size_t)rowB * DM); const float qa = rrA * F8_SA, qb = rrB * F8_SA;
#pragma unroll
      for (int i = 0; i < 8; ++i) { dA[lane + i * 64] = cvt4_fp8(xa[i][0] * qa, xa[i][1] * qa, xa[i][2] * qa, xa[i][3] * qa); dB[lane + i * 64] = cvt4_fp8(xq[i][0] * qb, xq[i][1] * qb, xq[i][2] * qb, xq[i][3] * qb); }
    } else {
#pragma unroll
      for (int i = 0; i < 8; ++i) { u32x2 w; w.x = cvt_pk_bf16(xa[i][0], xa[i][1]); w.y = cvt_pk_bf16(xa[i][2], xa[i][3]); *(u32x2*)(xb + (size_t)rowA * DM + lane * 4 + i * 256) = w;
        w.x = cvt_pk_bf16(xq[i][0], xq[i][1]); w.y = cvt_pk_bf16(xq[i][2], xq[i][3]); *(u32x2*)(xb + (size_t)rowB * DM + lane * 4 + i * 256) = w; }
    }
    if (lane == 0) { rstd[rowA] = rrA; rstd[rowB] = rrB; }
  }
}

__device__ __forceinline__ void phase_hid(KP p, int l) {
  const int lane = TIDX() & 63, gw = (BIDX() * 512 + TIDX()) >> 6, nw = (GDIM() * 512) >> 6;
  const float* w1 = inl(p, 10, l); const float* b1 = inl(p, 11, l); const float* w2 = inl(p, 12, l); const float* b2 = inl(p, 13, l);
  const float* w3 = inl(p, 14, l); const float* b3 = inl(p, 15, l); const float* fq = inl(p, 17, l);
  const float f = fq[lane];
  for (int pos = gw; pos < SEQ; pos += nw) {
    float z = 0.f;
    if (lane == 0) z = (float)pos / (float)(SEQ - 1);
    else if (lane < 33) { const int j = (lane - 1) & 15; const float band = 1e-4f + (float)j * ((15.0f - 1e-4f) / 15.0f);
      const float rev = (float)pos * band * (1.0f / (float)SEQ); z = lane < 17 ? __builtin_amdgcn_cosf(rev) : -__builtin_amdgcn_sinf(rev); }
    float a = b1[lane];
    for (int i = 0; i < 33; ++i) a += __int_as_float(__builtin_amdgcn_readlane(__float_as_int(z), i)) * w1[i * 64 + lane];
    float h = __builtin_amdgcn_sinf(f * a * 0.15915494309189535f);
    a = b2[lane];
    for (int i = 0; i < 64; ++i) a += __int_as_float(__builtin_amdgcn_readlane(__float_as_int(h), i)) * w2[i * 64 + lane];
    h = __builtin_amdgcn_sinf(f * a * 0.15915494309189535f);
    a = b3[lane];
    for (int i = 0; i < 64; ++i) a += __int_as_float(__builtin_amdgcn_readlane(__float_as_int(h), i)) * w3[i * 64 + lane];
    h = __builtin_amdgcn_sinf(f * a * 0.15915494309189535f);
    ((bf16_t*)(p->ws + O_HIDB))[(size_t)pos * 256 + lane] = f2bf(h);
  }
}

__device__ __forceinline__ void phase_filt(KP p, int l, float* ldsf) {
  const int tid = TIDX();
  const float* hid = (const float*)(p->ws + O_HID); const float* fw4 = inl(p, 16, l);
  float* TS = (float*)(p->ws + A_MB16);
  const float min_decay = -3.0701134573f, max_decay = -15.3505672866f;
  for (int tile = BIDX(); tile < 128 * 8; tile += GDIM()) {
    const int pt = tile >> 3, ct = tile & 7, pos0 = pt * 32, col = ct * 512 + tid, q = col >> 10, ch = col & 1023, o = q >> 1, dir = q & 1;
    __syncthreads();
    for (int e = tid; e < 32 * 64; e += 512) ldsf[e] = hid[(size_t)pos0 * 64 + e];
    __syncthreads();
    float acc[32];
#pragma unroll
    for (int i = 0; i < 32; ++i) acc[i] = 0.f;
    for (int i = 0; i < 64; i += 4) {
      const float wa = fw4[(size_t)i * 4096 + col], wb = fw4[(size_t)(i + 1) * 4096 + col], wc = fw4[(size_t)(i + 2) * 4096 + col], wd = fw4[(size_t)(i + 3) * 4096 + col];
#pragma unroll
      for (int pp = 0; pp < 32; ++pp) { const f32x4 h = *(const f32x4*)(ldsf + pp * 64 + i); acc[pp] += h[0] * wa + h[1] * wb + h[2] * wc + h[3] * wd; }
    }
    const float delta = fabsf(min_decay + (float)ch * ((max_decay - min_decay) / 1023.0f));
    float* stage = ldsf + 2048;
#pragma unroll
    for (int pp = 0; pp < 32; ++pp) {
      const int pos = pos0 + pp;
      stage[tid * 33 + pp] = acc[pp] * __expf(-((float)pos / (float)(SEQ - 1)) * delta) * (1.0f / 8192.0f);
    }
    __syncthreads();
    const int jj = tid & 31;
#pragma unroll 4
    for (int it = 0; it < 32; ++it) {
      const int row = it * 16 + (tid >> 5), rcol = ct * 512 + row, rch = rcol & 1023;
      float* dst = TS + (size_t)(o * 1024 + rch) * 8192; const float val = stage[row * 33 + jj]; const int pos = pos0 + jj;
      if (dir == 0) dst[pos] = val; else if (pos == 0) dst[4096] = 0.f; else dst[8192 - pos] = val;
    }
  }
  __syncthreads();
}

__device__ __forceinline__ f32x2 cmul(f32x2 a, f32x2 b) { return (f32x2){a.x * b.x - a.y * b.y, a.x * b.y + a.y * b.x}; }
template <bool INV> __device__ __forceinline__ void dft4(f32x2& a, f32x2& b, f32x2& c, f32x2& d) {
  const f32x2 s0 = a + c, s1 = a - c, s2 = b + d, s3 = b - d;
  const f32x2 js3 = INV ? (f32x2){-s3.y, s3.x} : (f32x2){s3.y, -s3.x};
  a = s0 + s2; c = s0 - s2; b = s1 + js3; d = s1 - js3;
}
#define XI(k) ((((k) & 3) * 4) + ((k) >> 2))
template <bool INV> __device__ __forceinline__ void dft16(f32x2 (&v)[16]) {
#pragma unroll
  for (int b = 0; b < 4; ++b) dft4<INV>(v[b], v[4 + b], v[8 + b], v[12 + b]);
  const float C1 = 0.92387953251f, S1 = 0.38268343236f, R2 = 0.70710678118f;
  const f32x2 W1 = {C1, INV ? S1 : -S1}, W2 = {R2, INV ? R2 : -R2}, W3 = {S1, INV ? C1 : -C1}, W4 = {0.f, INV ? 1.f : -1.f}, W6 = {-R2, INV ? R2 : -R2}, W9 = {-C1, INV ? -S1 : S1};
  v[4 * 1 + 1] = cmul(v[4 * 1 + 1], W1); v[4 * 1 + 2] = cmul(v[4 * 1 + 2], W2); v[4 * 1 + 3] = cmul(v[4 * 1 + 3], W3);
  v[4 * 2 + 1] = cmul(v[4 * 2 + 1], W2); v[4 * 2 + 2] = cmul(v[4 * 2 + 2], W4); v[4 * 2 + 3] = cmul(v[4 * 2 + 3], W6);
  v[4 * 3 + 1] = cmul(v[4 * 3 + 1], W3); v[4 * 3 + 2] = cmul(v[4 * 3 + 2], W6); v[4 * 3 + 3] = cmul(v[4 * 3 + 3], W9);
#pragma unroll
  for (int c = 0; c < 4; ++c) dft4<INV>(v[4 * c + 0], v[4 * c + 1], v[4 * c + 2], v[4 * c + 3]);
}
__device__ __forceinline__ void twiddle16(f32x2 (&v)[16], f32x2 w) {
  asm volatile("" : "+v"(w.x), "+v"(w.y));
  const f32x2 w2 = cmul(w, w), w3 = cmul(w2, w), w4 = cmul(w2, w2), w5 = cmul(w4, w), w6 = cmul(w4, w2), w7 = cmul(w4, w3), w8 = cmul(w4, w4);
  v[XI(1)] = cmul(v[XI(1)], w); v[XI(2)] = cmul(v[XI(2)], w2); v[XI(3)] = cmul(v[XI(3)], w3); v[XI(4)] = cmul(v[XI(4)], w4);
  v[XI(5)] = cmul(v[XI(5)], w5); v[XI(6)] = cmul(v[XI(6)], w6); v[XI(7)] = cmul(v[XI(7)], w7); v[XI(8)] = cmul(v[XI(8)], w8);
  v[XI(9)] = cmul(v[XI(9)], cmul(w8, w)); v[XI(10)] = cmul(v[XI(10)], cmul(w8, w2)); v[XI(11)] = cmul(v[XI(11)], cmul(w8, w3)); v[XI(12)] = cmul(v[XI(12)], cmul(w8, w4));
  v[XI(13)] = cmul(v[XI(13)], cmul(w8, w5)); v[XI(14)] = cmul(v[XI(14)], cmul(w8, w6)); v[XI(15)] = cmul(v[XI(15)], cmul(w8, w7));
}
__device__ __forceinline__ void twiddle16n(f32x2 (&v)[16], f32x2 w) {
  asm volatile("" : "+v"(w.x), "+v"(w.y));
  const f32x2 w2 = cmul(w, w), w3 = cmul(w2, w), w4 = cmul(w2, w2), w5 = cmul(w4, w), w6 = cmul(w4, w2), w7 = cmul(w4, w3), w8 = cmul(w4, w4);
  v[1] = cmul(v[1], w); v[2] = cmul(v[2], w2); v[3] = cmul(v[3], w3); v[4] = cmul(v[4], w4); v[5] = cmul(v[5], w5); v[6] = cmul(v[6], w6); v[7] = cmul(v[7], w7); v[8] = cmul(v[8], w8);
  v[9] = cmul(v[9], cmul(w8, w)); v[10] = cmul(v[10], cmul(w8, w2)); v[11] = cmul(v[11], cmul(w8, w3)); v[12] = cmul(v[12], cmul(w8, w4));
  v[13] = cmul(v[13], cmul(w8, w5)); v[14] = cmul(v[14], cmul(w8, w6)); v[15] = cmul(v[15], cmul(w8, w7));
}
__device__ __forceinline__ int PADI(int i) { return i + (i >> 5); }
__device__ __forceinline__ float dpp_xor1(float x) { return __int_as_float(__builtin_amdgcn_mov_dpp(__float_as_int(x), 0xB1, 0xF, 0xF, true)); }

struct FftCtx { f32x2 w1; int P1, P2, P3, n3, t31;
  __device__ __forceinline__ f32x2 w2f() const { int q = t31; asm volatile("" : "+v"(q)); const float r = -(float)q * (1.0f / 512.0f); return (f32x2){__builtin_amdgcn_cosf(r), __builtin_amdgcn_sinf(r)}; }
  __device__ __forceinline__ f32x2 w3f() const { int q = n3; asm volatile("" : "+v"(q)); const float r = -(float)q * (1.0f / 32.0f); return (f32x2){__builtin_amdgcn_cosf(r), __builtin_amdgcn_sinf(r)}; } };

__device__ __forceinline__ void fft_fwd2(f32x2 (&x)[16], f32x2 (&y)[16], const FftCtx& c, f32x2* bufA, f32x2* bufB) {
  dft16<false>(x); twiddle16(x, c.w1); __builtin_amdgcn_sched_barrier(0); dft16<false>(y); twiddle16(y, c.w1); __builtin_amdgcn_sched_barrier(0);
#pragma unroll
  for (int k = 0; k < 16; ++k) { bufA[c.P1 + k * 528] = x[XI(k)]; bufB[c.P1 + k * 528] = y[XI(k)]; }
  __syncthreads();
#pragma unroll
  for (int n = 0; n < 16; ++n) { x[n] = bufA[c.P2 + n * 33]; y[n] = bufB[c.P2 + n * 33]; }
  dft16<false>(x); twiddle16(x, c.w2f()); __builtin_amdgcn_sched_barrier(0); dft16<false>(y); twiddle16(y, c.w2f()); __builtin_amdgcn_sched_barrier(0);
#pragma unroll
  for (int k = 0; k < 16; ++k) { bufA[c.P2 + k * 33] = x[XI(k)]; bufB[c.P2 + k * 33] = y[XI(k)]; }
  __syncthreads();
#pragma unroll
  for (int n = 0; n < 16; ++n) { x[n] = bufA[c.P3 + n * 2]; y[n] = bufB[c.P3 + n * 2]; }
  dft16<false>(x); twiddle16(x, c.w3f()); __builtin_amdgcn_sched_barrier(0); dft16<false>(y); twiddle16(y, c.w3f()); __builtin_amdgcn_sched_barrier(0);
#pragma unroll
  for (int i = 0; i < 16; ++i) { const f32x2 o = {dpp_xor1(x[i].x), dpp_xor1(x[i].y)}; x[i] = c.n3 ? (o - x[i]) : (x[i] + o);
                                 const f32x2 q = {dpp_xor1(y[i].x), dpp_xor1(y[i].y)}; y[i] = c.n3 ? (q - y[i]) : (y[i] + q); }
}
__device__ __forceinline__ void fft_inv2(f32x2 (&x)[16], f32x2 (&y)[16], const FftCtx& c, f32x2* bufA, f32x2* bufB) {
  f32x2 u[16], w[16];
#pragma unroll
  for (int k = 0; k < 16; ++k) { const f32x2 own = x[XI(k)]; const f32x2 o = {dpp_xor1(own.x), dpp_xor1(own.y)}; u[k] = c.n3 ? (o - own) : (own + o);
                                 const f32x2 owy = y[XI(k)]; const f32x2 q = {dpp_xor1(owy.x), dpp_xor1(owy.y)}; w[k] = c.n3 ? (q - owy) : (owy + q); }
  { const f32x2 q3 = c.w3f(); twiddle16n(u, (f32x2){q3.x, -q3.y}); } dft16<true>(u); __builtin_amdgcn_sched_barrier(0); { const f32x2 q3 = c.w3f(); twiddle16n(w, (f32x2){q3.x, -q3.y}); } dft16<true>(w); __builtin_amdgcn_sched_barrier(0);
#pragma unroll
  for (int n = 0; n < 16; ++n) { bufA[c.P3 + n * 2] = u[XI(n)]; bufB[c.P3 + n * 2] = w[XI(n)]; }
  __syncthreads();
#pragma unroll
  for (int k = 0; k < 16; ++k) { u[k] = bufA[c.P2 + k * 33]; w[k] = bufB[c.P2 + k * 33]; }
  { const f32x2 q2 = c.w2f(); twiddle16n(u, (f32x2){q2.x, -q2.y}); } dft16<true>(u); __builtin_amdgcn_sched_barrier(0); { const f32x2 q2 = c.w2f(); twiddle16n(w, (f32x2){q2.x, -q2.y}); } dft16<true>(w); __builtin_amdgcn_sched_barrier(0);
#pragma unroll
  for (int n = 0; n < 16; ++n) { bufA[c.P2 + n * 33] = u[XI(n)]; bufB[c.P2 + n * 33] = w[XI(n)]; }
  __syncthreads();
#pragma unroll
  for (int k = 0; k < 16; ++k) { u[k] = bufA[c.P1 + k * 528]; w[k] = bufB[c.P1 + k * 528]; }
  twiddle16n(u, (f32x2){c.w1.x, -c.w1.y}); dft16<true>(u); __builtin_amdgcn_sched_barrier(0); twiddle16n(w, (f32x2){c.w1.x, -c.w1.y}); dft16<true>(w); __builtin_amdgcn_sched_barrier(0);
#pragma unroll
  for (int i = 0; i < 16; ++i) { x[i] = u[i]; y[i] = w[i]; }
}

__device__ __forceinline__ float sconv(const bf16_t* col, int l, float w0, float w1, float w2, float cb) {
  const float um = bf2f(col[l - 1]), u0 = bf2f(col[l]), up = bf2f(col[l + 1]);
  return cb + w0 * (l > 0 ? um : 0.f) + w1 * u0 + w2 * (l < SEQ - 1 ? up : 0.f);
}

__device__ __forceinline__ void phase_hyena(KP p, int l, unsigned char* ldsraw) {
  f32x2* bufA = (f32x2*)ldsraw; f32x2* bufB = bufA + 8448;
  const int t = TIDX();
  FftCtx c; c.P1 = t + (t >> 5); c.P2 = (t >> 5) * 528 + (t & 31); c.P3 = (t >> 1) * 33 + (t & 1); c.n3 = t & 1; c.t31 = t & 31;
  { const float r1 = -(float)t * (1.0f / 8192.0f); c.w1 = (f32x2){__builtin_amdgcn_cosf(r1), __builtin_amdgcn_sinf(r1)}; }
  const float* TS = (const float*)(p->ws + A_MB16);
  const float* cw = inl(p, 8, l); const float* cbp = inl(p, 9, l); const float* dsk = inl(p, 18, l);
  const bf16_t* HT = (const bf16_t*)(p->ws + A_HTFT);
  bf16_t* Z2T = (bf16_t*)(p->ws + A_Z2T);
  f32x2* Hs = (f32x2*)(p->ws + A_HST + (size_t)BIDX() * 131072);
  for (int ch = BIDX(); ch < 1024; ch += GDIM()) {
    const float* tsa = TS + (size_t)ch * 8192; const float* tsb = TS + (size_t)(1024 + ch) * 8192;
    f32x2 x[16], y[16];
    { int tt = t; asm volatile("" : "+v"(tt));
#pragma unroll
      for (int i = 0; i < 16; ++i) { x[i] = (f32x2){tsa[i * 512 + tt], 0.f}; y[i] = (f32x2){tsb[i * 512 + tt], 0.f}; } }
    fft_fwd2(x, y, c, bufA, bufB);
    { int tt = t; asm volatile("" : "+v"(tt));
#pragma unroll
      for (int k = 0; k < 16; ++k) { Hs[k * 512 + tt] = x[XI(k)]; Hs[8192 + k * 512 + tt] = y[XI(k)]; } }
    float w0[3], w1[3], w2[3], cb[3];
#pragma unroll
    for (int q = 0; q < 3; ++q) { const int col = q * 1024 + ch; w0[q] = cw[col]; w1[q] = cw[3072 + col]; w2[q] = cw[6144 + col]; cb[q] = cbp[col]; }
    const float d1 = dsk[ch], d2 = dsk[1024 + ch];
    const bf16_t* colv = HT + (size_t)ch * NTOK; const bf16_t* colg = HT + (size_t)(1024 + ch) * NTOK; const bf16_t* colh = HT + (size_t)(2048 + ch) * NTOK;
    unsigned zp[8], zq[8];
    { int t1 = t; asm volatile("" : "+v"(t1));
#pragma unroll
      for (int n1 = 0; n1 < 8; ++n1) { const int pos = n1 * 512 + t1;
        zp[n1] = cvt_pk_bf16(sconv(colv, pos, w0[0], w1[0], w2[0], cb[0]), sconv(colv + SEQ, pos, w0[0], w1[0], w2[0], cb[0]));
        zq[n1] = cvt_pk_bf16(sconv(colv + 2 * SEQ, pos, w0[0], w1[0], w2[0], cb[0]), sconv(colv + 3 * SEQ, pos, w0[0], w1[0], w2[0], cb[0])); } }
#pragma unroll
    for (int o = 0; o < 2; ++o) {
      const float dd = o ? d2 : d1; const bf16_t* gc = o ? colh : colg; const int q = 1 + o;
#pragma unroll
      for (int i = 0; i < 8; ++i) { x[i] = (f32x2){bf2f(zp[i] & 0xffffu), bf2f(zp[i] >> 16)}; x[8 + i] = (f32x2){0.f, 0.f}; y[i] = (f32x2){bf2f(zq[i] & 0xffffu), bf2f(zq[i] >> 16)}; y[8 + i] = (f32x2){0.f, 0.f}; }
      fft_fwd2(x, y, c, bufA, bufB);
      { int tt = t; asm volatile("" : "+v"(tt));
#pragma unroll
        for (int k = 0; k < 16; ++k) { const f32x2 hh = Hs[o * 8192 + k * 512 + tt]; x[XI(k)] = cmul(x[XI(k)], hh); y[XI(k)] = cmul(y[XI(k)], hh); } }
      fft_inv2(x, y, c, bufA, bufB);
      { int t2 = t; asm volatile("" : "+v"(t2));
#pragma unroll
        for (int n1 = 0; n1 < 8; ++n1) { const int pos = n1 * 512 + t2; const f32x2 a = x[XI(n1)], b = y[XI(n1)];
          const float r0 = sconv(gc, pos, w0[q], w1[q], w2[q], cb[q]) * (a.x + dd * bf2f(zp[n1] & 0xffffu)), r1 = sconv(gc + SEQ, pos, w0[q], w1[q], w2[q], cb[q]) * (a.y + dd * bf2f(zp[n1] >> 16));
          const float r2 = sconv(gc + 2 * SEQ, pos, w0[q], w1[q], w2[q], cb[q]) * (b.x + dd * bf2f(zq[n1] & 0xffffu)), r3 = sconv(gc + 3 * SEQ, pos, w0[q], w1[q], w2[q], cb[q]) * (b.y + dd * bf2f(zq[n1] >> 16));
          zp[n1] = cvt_pk_bf16(r0, r1); zq[n1] = cvt_pk_bf16(r2, r3); } }
    }
    { bf16_t* o0 = Z2T + (size_t)ch * NTOK; int t3 = t; asm volatile("" : "+v"(t3));
#pragma unroll
      for (int n1 = 0; n1 < 8; ++n1) { o0[n1 * 512 + t3] = (bf16_t)(zp[n1] & 0xffffu); o0[SEQ + n1 * 512 + t3] = (bf16_t)(zp[n1] >> 16); o0[2 * SEQ + n1 * 512 + t3] = (bf16_t)(zq[n1] & 0xffffu); o0[3 * SEQ + n1 * 512 + t3] = (bf16_t)(zq[n1] >> 16); } }
  }
  __syncthreads();
}

__device__ __forceinline__ void phase_poolt(KP p, unsigned char* ldsraw) {
  const int tid = TIDX();
  bf16_t* tl = (bf16_t*)ldsraw;
  const bf16_t* Z2T = (const bf16_t*)(p->ws + A_Z2T); bf16_t* ZC = (bf16_t*)(p->ws + A_ZCAT); const bf16_t* PN = (const bf16_t*)(p->ws + A_PN);
  for (int tile = BIDX(); tile < 16 * 256; tile += GDIM()) {
    const int c0 = (tile & 15) * 64, t0 = (tile >> 4) * 64;
    const int i = tid >> 3, jj = (tid & 7) * 8;
    __syncthreads();
    { const u32x4 w = *(const u32x4*)(Z2T + (size_t)(c0 + i) * NTOK + t0 + jj);
      *(u32x4*)(tl + i * 72 + jj) = w; }
    __syncthreads();
    { unsigned e[8];
#pragma unroll
      for (int q = 0; q < 8; ++q) e[q] = tl[(jj + q) * 72 + i];
      u32x4 w; w.x = e[0] | (e[1] << 16); w.y = e[2] | (e[3] << 16); w.z = e[4] | (e[5] << 16); w.w = e[6] | (e[7] << 16);
      *(u32x4*)(ZC + (size_t)(t0 + i) * 2560 + c0 + jj) = w; }
  }
  for (size_t e = (size_t)BIDX() * 512 + tid; e < (size_t)NTOK * 64; e += (size_t)GDIM() * 512) {
    const int tok = (int)(e >> 6), c8 = (int)(e & 63) * 8, g = c8 >> 7, w = 2 << g, before = w >> 1, after = w - 1 - before;
    const int b = tok >> 12, l = tok & 4095;
    int lo = l - before; if (lo < 0) lo = 0; int hi = l + after; if (hi > SEQ - 1) hi = SEQ - 1;
    float s[8];
#pragma unroll
    for (int q = 0; q < 8; ++q) s[q] = 0.f;
    u32x4 wv[16];
#pragma unroll
    for (int j = 0; j < 16; ++j) { int r = l - before + j; r = r < 0 ? 0 : (r > SEQ - 1 ? SEQ - 1 : r); wv[j] = *(const u32x4*)(PN + (size_t)(b * SEQ + r) * 6656 + c8); }
#pragma unroll
    for (int j = 0; j < 16; ++j) { const int r = l - before + j; const float m = (j < w && r >= 0 && r <= SEQ - 1) ? 1.0f : 0.0f;
      s[0] += m * bf2f(wv[j].x & 0xffff); s[1] += m * bf2f(wv[j].x >> 16); s[2] += m * bf2f(wv[j].y & 0xffff); s[3] += m * bf2f(wv[j].y >> 16);
      s[4] += m * bf2f(wv[j].z & 0xffff); s[5] += m * bf2f(wv[j].z >> 16); s[6] += m * bf2f(wv[j].w & 0xffff); s[7] += m * bf2f(wv[j].w >> 16); }
    const u32x4 sv = *(const u32x4*)(PN + (size_t)tok * 6656 + c8);
    const float inv = 1.0f / (float)(hi - lo + 1);
    float o[8];
    o[0] = s[0] * inv - bf2f(sv.x & 0xffff); o[1] = s[1] * inv - bf2f(sv.x >> 16); o[2] = s[2] * inv - bf2f(sv.y & 0xffff); o[3] = s[3] * inv - bf2f(sv.y >> 16);
    o[4] = s[4] * inv - bf2f(sv.z & 0xffff); o[5] = s[5] * inv - bf2f(sv.z >> 16); o[6] = s[6] * inv - bf2f(sv.w & 0xffff); o[7] = s[7] * inv - bf2f(sv.w >> 16);
    u32x4 w4; w4.x = cvt_pk_bf16(o[0], o[1]); w4.y = cvt_pk_bf16(o[2], o[3]); w4.z = cvt_pk_bf16(o[4], o[5]); w4.w = cvt_pk_bf16(o[6], o[7]);
    *(u32x4*)(ZC + (size_t)tok * 2560 + 2048 + c8) = w4;
  }
  __syncthreads();
}

#define XB_TMO      128
#define XB_XCNT(j)  (256  + 64 * (j))
#define XB_XSUB(j)  (1280 + 64 * (j))
#define XB_XGEN(j)  (2304 + 64 * (j))
#define XB_TOP      3328
#define XB_TOPGEN   3392
#define XCD_BAR_WORDS 3456
#define XB_SPIN_CAP (1u << 18)

__device__ __forceinline__ unsigned xb_ld(unsigned* p)              { return __hip_atomic_load(p, __ATOMIC_RELAXED, __HIP_MEMORY_SCOPE_AGENT); }
__device__ __forceinline__ unsigned xb_add(unsigned* p, unsigned v) { return __hip_atomic_fetch_add(p, v, __ATOMIC_RELAXED, __HIP_MEMORY_SCOPE_AGENT); }
__device__ __forceinline__ unsigned xb_xcc_id() { return (unsigned)__builtin_amdgcn_s_getreg((3 << 11) | 20) & 0xFu; }
#define XB_SPIN(cond, bar) do { unsigned _sp = 0; while (cond) { __builtin_amdgcn_s_sleep(1); \
    if ((++_sp & 255u) == 0u) { if (xb_ld(&(bar)[XB_TMO])) break; if (_sp > XB_SPIN_CAP) { atomicAdd(&(bar)[XB_TMO], 1u); break; } } } } while (0)

struct XcdBarrier {
    unsigned* bar; unsigned x;
    volatile LAS unsigned* st;
};

__device__ __forceinline__ XcdBarrier xcd_barrier_post(unsigned* bar, volatile LAS unsigned* st) {
    XcdBarrier b; b.bar = bar; b.x = xb_xcc_id(); b.st = st;
    if (TIDX() == 0) (void)xb_add(&bar[XB_XCNT(b.x)], 1u);
    return b;
}
__device__ __forceinline__ void xcd_barrier_complete(unsigned* bar, unsigned x, unsigned& nloc, unsigned& nx) {
    const unsigned G = (unsigned)GDIM();
    unsigned sum, cnt, mine, sp = 0u;
    for (;;) {
        sum = 0u; cnt = 0u; mine = 0u;
#pragma unroll
        for (unsigned j = 0; j < 16; ++j) { const unsigned c = xb_ld(&bar[XB_XCNT(j)]); sum += c; cnt += (c > 0u) ? 1u : 0u; mine = (j == x) ? c : mine; }
        if (sum == G) break;
        __builtin_amdgcn_s_sleep(1);
        if ((++sp & 255u) == 0u) { if (xb_ld(&bar[XB_TMO])) break; if (sp > XB_SPIN_CAP) { atomicAdd(&bar[XB_TMO], 1u); break; } }
    }
    nloc = mine > 0u ? mine : 1u; nx = cnt > 0u ? cnt : 1u;
}

__device__ __forceinline__ void xcd_barrier(const XcdBarrier& b) {
    asm volatile("s_waitcnt vmcnt(0)" ::: "memory");
    __syncthreads();
    if (TIDX() == 0) {
        unsigned* bar = b.bar; asm volatile("" : "+s"(bar));
        __builtin_amdgcn_s_waitcnt(0);
        unsigned nloc = b.st[0], nx = b.st[1];
        if (nloc == 0u) { xcd_barrier_complete(bar, b.x, nloc, nx); b.st[0] = nloc; b.st[1] = nx; }
        const unsigned old = xb_add(&bar[XB_XSUB(b.x)], 1u);
        const unsigned gen = old / nloc;
        if (old + 1u == (gen + 1u) * nloc) {
            __builtin_amdgcn_fence(__ATOMIC_RELEASE, "agent");
            asm volatile("s_waitcnt vmcnt(0)" ::: "memory");
            const unsigned og = xb_add(&bar[XB_TOP], 1u);
            const unsigned tg = og / nx;
            if (og + 1u == (tg + 1u) * nx) xb_add(&bar[XB_TOPGEN], 1u);
            else XB_SPIN(xb_ld(&bar[XB_TOPGEN]) == tg, bar);
            __builtin_amdgcn_fence(__ATOMIC_ACQUIRE, "agent");
            xb_add(&bar[XB_XGEN(b.x)], 1u);
            asm volatile("s_waitcnt vmcnt(0)" ::: "memory");
        } else {
            XB_SPIN(xb_ld(&bar[XB_XGEN(b.x)]) == gen, bar);
            __builtin_amdgcn_fence(__ATOMIC_ACQUIRE, "agent");
            asm volatile("s_waitcnt vmcnt(0)" ::: "memory");
        }
    }
    __syncthreads();
}


__device__ __forceinline__ void run_phase(KP p, int ph, unsigned char* lds) {
  LAS unsigned char* ldsl = (LAS unsigned char*)lds;
  float* ldsf = (float*)lds;
  pg8::Sched S;
  if (ph == 0) {
    phase_conv(p, 0, ldsf);
    phase_dftm(p, ldsf);
    phase_prep(p);
    phase_hid(p, 0);
    return;
  }
  const int l = (ph - 1) / 17, k = (ph - 1) % 17;
#define WSDEF unsigned char* ws = p->ws; asm volatile("" : "+s"(ws)); bf16_t* wb = (bf16_t*)ws;
  switch (k) {
    case 0: case 14: { WSDEF
      if (l == 1) {
        pg8::EpiSwiGLU E{(bf16_t*)(ws + A_H), nullptr, 1.0f / (F8_SA * F8_SW), k == 14 ? 1 : 0};
        S.init(0, ws + O_XB8, wb + (k == 0 ? O_WGU1 : O_WGU2) / 2, DM / 2, DM / 2, NTOK, 2 * DFF, 0); pg8::gemm_phase<pg8::EpiSwiGLU, true>(ldsl, S, DM / 128, E);
      } else {
        pg8::EpiSwiGLU E{(bf16_t*)(ws + A_H), (const float*)(ws + O_RSTD), 1.0f, 0};
        S.init(0, ws + O_XB, wb + (k == 0 ? O_WGU1 : O_WGU2) / 2, DM, DM, NTOK, 2 * DFF, 0); pg8::gemm_phase(ldsl, S, DM / 64, E);
      } } break;
    case 1: case 15: { WSDEF
      if (k == 15 && l == 1) {
        pg8::EpiY E{(bf16_t*)(ws + A_Y), (float*)(ws + O_PART), 1.0f / (F8_SH * F8_SW)};
        S.init(0, ws + A_H, wb + O_WD2 / 2, DFF / 2, DFF / 2, NTOK, DM, 0); pg8::gemm_phase<pg8::EpiY, true>(ldsl, S, DFF / 128, E);
      } else {
        pg8::EpiY E{(bf16_t*)(ws + A_Y), (float*)(ws + O_PART), 1.0f};
        S.init(0, ws + A_H, wb + (k == 1 ? O_WD1 : O_WD2) / 2, DFF, DFF, NTOK, DM, 0); pg8::gemm_phase(ldsl, S, DFF / 64, E);
      } } break;
    case 2: phase_resid(p, (l == 0) ? p->in[0] : p->out, inl(p, 5, l), 0.5f, false); break;
    case 3: { WSDEF
      { pg8::EpiColBf16 E{(bf16_t*)(ws + A_HTFT), (const float*)(ws + O_RSTD), 1}; S.init(0, wb + O_WINT / 2, ws + O_XB, DM, DM, 4096, NTOK, 0); pg8::gemm_phase(ldsl, S, DM / 64, E); }
      { pg8::EpiRowBf16 E{(bf16_t*)(ws + A_PN), 6656, (const float*)(ws + O_RSTD), 1, 512}; S.init(0, ws + O_XB, wb + O_WINN / 2, DM, DM, NTOK, 6656, 0); pg8::gemm_phase(ldsl, S, DM / 64, E); }
      { pg8::EpiRowBf16 E{(bf16_t*)(ws + O_KB), DM, (const float*)(ws + O_RSTDM), 0, 0}; S.init(0, ws + O_MB, wb + O_WK / 2, DM, DM, MEMROWS, DM, 0); S.c = (S.c + 128) & 255; pg8::gemm_phase(ldsl, S, DM / 64, E); }
      { pg8::EpiColBf16 E{(bf16_t*)(ws + O_VT), (const float*)(ws + O_RSTDM), 0}; S.init(0, wb + O_WV / 2, ws + O_MB, DM, DM, DM, MEMROWS, 0); S.c = (S.c + 96) & 255; pg8::gemm_phase(ldsl, S, DM / 64, E); }
      { pg8::EpiFilt E{(float*)(ws + A_MB16)}; S.init(0, ws + O_W4T, ws + O_HIDB, 256, 256, 4096, 4096, 0); pg8::gemm_phase(ldsl, S, 256 / 64, E); }
    } break;
    case 4: { WSDEF
#ifndef NO_HYENA
      phase_hyena(p, l, lds);
#endif
      pg8::EpiRowBf16 E{(bf16_t*)(ws + A_ZCAT), 2560, nullptr, 0, 0}; S.init(3, ws + O_DFTM, ws + A_HTFT + (size_t)3072 * NTOK * 2, 8192, 8192, 256 * 16, 256 * 16, 0); pg8::gemm_phase(ldsl, S, 4096 / 64, E);
    } break;
    case 5: phase_poolt(p, lds); break;
    case 6: { WSDEF
      float* MF = (float*)(ws + A_MF); bf16_t* MB16 = (bf16_t*)(ws + A_MB16); const bf16_t* PN = (const bf16_t*)(ws + A_PN);
      { pg8::EpiMerge<0> E{MF, MB16, PN}; S.init(0, ws + A_ZCAT, wb + O_WM / 2, 2560, 2560, NTOK, DM, 0); pg8::gemm_phase(ldsl, S, 1024 / 64, E); }
      { pg8::EpiMerge<1> E{MF, MB16, PN}; S.init(0, ws + A_ZCAT, wb + O_WM / 2, 2560, 2560, NTOK, DM, 1024); pg8::gemm_phase(ldsl, S, 1024 / 64, E); }
      { pg8::EpiMerge<2> E{MF, MB16, PN}; S.init(0, ws + A_ZCAT, wb + O_WM / 2, 2560, 2560, NTOK, DM, 2048); pg8::gemm_phase(ldsl, S, 512 / 64, E); }
    } break;
    case 7: case 12: { WSDEF
      pg8::EpiY E{(bf16_t*)(ws + A_Y), (float*)(ws + O_PART), 1.0f};
      S.init(0, ws + (k == 7 ? A_MB16 : A_O), wb + (k == 7 ? O_WOUT : O_WO) / 2, DM, DM, NTOK, DM, 0); pg8::gemm_phase(ldsl, S, DM / 64, E); } break;
    case 8: phase_resid(p, p->out, inl(p, 24, l), 1.0f, false); break;
    case 9: { WSDEF pg8::EpiRowBf16 E{(bf16_t*)(ws + A_Q), DM, (const float*)(ws + O_RSTD), 0, 0}; S.init(0, ws + O_XB, wb + O_WQ / 2, DM, DM, NTOK, DM, 0); pg8::gemm_phase(ldsl, S, DM / 64, E); } break;
    case 10: { WSDEF pg8::EpiSoftmax E{(bf16_t*)(ws + A_P), 0.044194173824159216f * 1.4426950408889634f}; S.init(1, ws + A_Q, ws + O_KB, DM, DM, 256 * 16, 256 * 16, 0); pg8::gemm_phase(ldsl, S, 512 / 64, E); } break;
    case 11: { WSDEF pg8::EpiRowBf16 E{(bf16_t*)(ws + A_O), DM, nullptr, 0, 0}; S.init(2, ws + A_P, ws + O_VT, 1024, 1024, 256 * 32, 256 * 16, 0); pg8::gemm_phase(ldsl, S, 256 / 64, E); } break;
    case 13: phase_resid(p, p->out, inl(p, 30, l), 1.0f, l == 1); break;
    case 16: phase_resid(p, p->out, inl(p, 34, l), 0.5f, l == 0);
#ifndef NO_CONV
      if (l == 0) { phase_conv(p, 1, ldsf); phase_hid(p, 1); }
#endif
      break;
    default: break;
  }
}

__global__ void __launch_bounds__(512, 2) mk_fwd(Params p) {
  unsigned char* lds = g_lds;
  cg::grid_group grid = cg::this_grid();
  volatile LAS unsigned* st = (volatile LAS unsigned*)((LAS unsigned char*)lds + (LDS_BYTES - 16));
  { const int tid0 = (int)threadIdx.x;
    const unsigned hw = (unsigned)__builtin_amdgcn_s_getreg(((6 - 1) << 11) | 4) & 63u;
    if ((tid0 & 63) == 0) *(volatile LAS int*)((LAS unsigned char*)lds + WTAB_OFF + hw * 4) = tid0 >> 6;
    if (tid0 == 0) { st[0] = 0u; st[1] = 0u; } }
  __syncthreads();
  const XcdBarrier xb = xcd_barrier_post((unsigned*)(p.ws + O_BAR), st);
#ifndef REP_K
#define REP_K -1
#endif
  { KP kp = (KP)__builtin_amdgcn_kernarg_segment_ptr(); asm volatile("" : "+s"(kp));
    run_phase(kp, 0, lds); }
  grid.sync();
  for (int ph = 1; ph < 35; ++ph) {
    int nrep = 1;
    if (REP_K >= 0 && REP_K < 17 && (ph - 1) % 17 == REP_K && (REP_K != 2 || ph < 18)) nrep = 2;
    for (int r = 0; r < nrep; ++r) {
      KP kp = (KP)__builtin_amdgcn_kernarg_segment_ptr(); asm volatile("" : "+s"(kp));
      run_phase(kp, ph, lds);
      if (ph != 34 || r != nrep - 1) xcd_barrier(xb);
    }
  }
}

extern "C" void kernel_launch(void* const* d_in, const int* in_sizes, int n_in, void* d_out, int out_size,
                              void* d_ws, size_t ws_size, hipStream_t stream) {
  static int grid_blocks = 0;
  if (!grid_blocks) {
    int dev = 0, cus = 0, per_cu = 0;
    (void)hipGetDevice(&dev);
    (void)hipDeviceGetAttribute(&cus, hipDeviceAttributeMultiprocessorCount, dev);
    (void)hipFuncSetAttribute((const void*)mk_fwd, hipFuncAttributeMaxDynamicSharedMemorySize, LDS_BYTES);
    (void)hipOccupancyMaxActiveBlocksPerMultiprocessor(&per_cu, (const void*)mk_fwd, 512, LDS_BYTES);
    if (per_cu < 1) per_cu = 1;
    grid_blocks = cus * per_cu;
    if (grid_blocks != 256 || ws_size < A_END || n_in != NIN)
      fprintf(stderr, "kernel_launch: unexpected configuration: grid %d (cus %d x %d), ws %zu (need %zu), n_in %d\n", grid_blocks, cus, per_cu, ws_size, (size_t)A_END, n_in);
  }
  (void)hipMemsetAsync((char*)d_ws + O_BAR, 0, 16384, stream);
  Params p{};
  for (int i = 0; i < NIN; ++i) { p.in[i] = (const float*)d_in[i]; p.lsz[i] = in_sizes[i] / 2; }
  p.out = (float*)d_out; p.ws = (unsigned char*)d_ws; p.pad = 0;
  void* args[] = {&p};
  hipError_t e = hipLaunchCooperativeKernel((void*)mk_fwd, dim3(grid_blocks), dim3(512), args, LDS_BYTES, stream);
  if (e != hipSuccess) fprintf(stderr, "cooperative launch failed: %s (grid %d)\n", hipGetErrorString(e), grid_blocks);
}
```

```cpp
#include <hip/hip_runtime.h>
#include <hip/hip_cooperative_groups.h>
#include <cstdio>
namespace cg = cooperative_groups;

#define LAS __attribute__((address_space(3)))
typedef unsigned short bf16_t;
typedef short bf16x8 __attribute__((ext_vector_type(8)));
typedef float f32x4 __attribute__((ext_vector_type(4)));
typedef float f32x2 __attribute__((ext_vector_type(2)));
typedef unsigned u32x4 __attribute__((ext_vector_type(4)));
typedef unsigned u32x2 __attribute__((ext_vector_type(2)));

constexpr int NTOK = 16384, DM = 2048, DFF = 5632, SEQ = 4096, NB = 4, MEMROWS = 1024;
constexpr int NIN = 35;
constexpr float RMS_EPS = 1e-6f;
constexpr float F8_SA = 16.0f, F8_SW = 512.0f, F8_SH = 8.0f;
constexpr int LDS_BYTES = 137216;

constexpr size_t E_WGU = 23068672, E_WD = 11534336, E_WINT = 8388608, E_WINN = 13631488, E_WM = 5242880, E_SQ = 4194304;
constexpr size_t O_WGU1 = 0, O_WD1 = O_WGU1 + 2 * E_WGU, O_WINT = O_WD1 + 2 * E_WD, O_WINN = O_WINT + 2 * E_WINT, O_WM = O_WINN + 2 * E_WINN,
                 O_WOUT = O_WM + 2 * E_WM, O_WQ = O_WOUT + 2 * E_SQ, O_WK = O_WQ + 2 * E_SQ, O_WV = O_WK + 2 * E_SQ, O_WO = O_WV + 2 * E_SQ,
                 O_WGU2 = O_WO + 2 * E_SQ, O_WD2 = O_WGU2 + 2 * E_WGU, O_WEND = O_WD2 + 2 * E_WD;
constexpr size_t O_XB = O_WEND, O_DFTM = O_XB + (size_t)NTOK * DM * 2, O_MB = O_DFTM + (size_t)4096 * 8192 * 2, O_KB = O_MB + (size_t)MEMROWS * DM * 2,
                 O_VT = O_KB + (size_t)MEMROWS * DM * 2, O_HID = O_VT + (size_t)MEMROWS * DM * 2, O_PART = O_HID + (size_t)4096 * 64 * 4,
                 O_RSTD = O_PART + (size_t)NTOK * 32 * 4, O_RSTDM = O_RSTD + (size_t)NTOK * 4, O_BAR = O_RSTDM + 4096, O_ARENA = O_BAR + 16384;
constexpr size_t A_HTFT = O_ARENA, A_PN = A_HTFT + (size_t)4096 * NTOK * 2, A_ZCAT = A_PN + (size_t)NTOK * 6656 * 2, A_MB16 = A_ZCAT + (size_t)NTOK * 2560 * 2,
                 A_HST = A_MB16 + (size_t)NTOK * DM * 2, A_Z2T = A_HST + (size_t)256 * 131072, O_XB8 = A_Z2T + (size_t)1024 * NTOK * 2, O_W4T = O_XB8 + (size_t)NTOK * DM, O_HIDB = O_W4T + (size_t)4096 * 256 * 2, A_END = O_HIDB + (size_t)4096 * 256 * 2;
constexpr size_t A_H = O_ARENA, A_Y = A_PN + (size_t)NTOK * 2560 * 2  , A_MF = A_HTFT, A_Q = O_ARENA, A_P = A_Q + (size_t)NTOK * DM * 2,
                 A_O = A_P + (size_t)NTOK * 1024 * 2;
static_assert(A_Y + (size_t)NTOK * DM * 4 <= A_ZCAT, "y must fit in PN tail");
static_assert(A_O + (size_t)NTOK * DM * 2 <= A_Y, "attention buffers below y");
static_assert(A_H + (size_t)NTOK * DFF * 2 <= A_Y, "H below y");

struct Params {
  const float* in[NIN];
  float* out;
  unsigned char* ws;
  int lsz[NIN];
  int pad;
};

typedef const __attribute__((address_space(4))) Params* KP;
constexpr int WTAB_OFF = LDS_BYTES - 16 - 256;
extern __shared__ __attribute__((aligned(16))) unsigned char g_lds[];
__device__ __forceinline__ int TIDX() {
  int lane; asm volatile("v_mbcnt_lo_u32_b32 %0, -1, 0\n\tv_mbcnt_hi_u32_b32 %0, -1, %0" : "=v"(lane));
  const unsigned hw = (unsigned)__builtin_amdgcn_s_getreg(((6 - 1) << 11) | 4) & 63u;
  const int wave = *(volatile LAS int*)((LAS unsigned char*)g_lds + WTAB_OFF + hw * 4);
  return wave * 64 + lane;
}
__device__ __forceinline__ int BIDX() { int b = __builtin_amdgcn_workgroup_id_x(); asm volatile("" : "+s"(b)); return b; }
__device__ __forceinline__ int GDIM() { int g = (int)__ockl_get_num_groups(0); asm volatile("" : "+s"(g)); return g; }
__device__ __forceinline__ unsigned cvt_pk_bf16(float lo, float hi) { unsigned r; asm("v_cvt_pk_bf16_f32 %0, %1, %2" : "=v"(r) : "v"(lo), "v"(hi)); return r; }
__device__ __forceinline__ unsigned cvt4_fp8(float a, float b, float c, float d) { int w = 0; w = __builtin_amdgcn_cvt_pk_fp8_f32(a, b, w, false); w = __builtin_amdgcn_cvt_pk_fp8_f32(c, d, w, true); return (unsigned)w; }
__device__ __forceinline__ float bf2f(unsigned b) { return __uint_as_float(b << 16); }
__device__ __forceinline__ bf16_t f2bf(float f) { return (bf16_t)(cvt_pk_bf16(f, 0.f) & 0xffffu); }
__device__ __forceinline__ float shfl_xor_f(float v, int m) { const int lane = TIDX() & 63; return __int_as_float(__builtin_amdgcn_ds_bpermute((lane ^ m) << 2, __float_as_int(v))); }
__device__ __forceinline__ float wave_sum(float v) {
  v += __int_as_float(__builtin_amdgcn_ds_swizzle(__float_as_int(v), (16 << 10) | 0x1F));
  v += __int_as_float(__builtin_amdgcn_ds_swizzle(__float_as_int(v), (8 << 10) | 0x1F));
  v += __int_as_float(__builtin_amdgcn_ds_swizzle(__float_as_int(v), (4 << 10) | 0x1F));
  v += __int_as_float(__builtin_amdgcn_ds_swizzle(__float_as_int(v), (2 << 10) | 0x1F));
  v += __int_as_float(__builtin_amdgcn_ds_swizzle(__float_as_int(v), (1 << 10) | 0x1F));
  return __int_as_float(__builtin_amdgcn_readlane(__float_as_int(v), 0)) + __int_as_float(__builtin_amdgcn_readlane(__float_as_int(v), 32));
}

namespace pg8 {
constexpr int BM = 256, BK = 64, HALF = 128, HTB = HALF * BK * 2, STAGE_BYTES = 8 * HTB, NXCD = 8, WGM = 8;
__device__ __forceinline__ int lds_byte(int r, int c) { const int st = (r >> 4) * 2 + (c >> 5), rr = r & 15, cc = c & 31, ob = rr * 64 + cc * 2; return st * 1024 + (ob ^ (((ob >> 9) & 1) << 5)); }
__device__ __forceinline__ void stage_rc(int b, int& R, int& C) { const int st = b / 1024, sb = b % 1024, swz = sb ^ (((sb >> 9) & 1) << 5); R = (st >> 1) * 16 + swz / 64; C = (st & 1) * 32 + (swz % 64) / 2; }
__device__ __forceinline__ int perm32(int rho) { const int n = rho >> 4, i = rho & 15; return 8 * (i >> 2) + 4 * n + (i & 3); }

struct Unit { const char* a; const char* b; int pm, pn; };

struct Sched {
  int mode; const char* A; const char* B; int lda, ldb, nM, nN, nwg, G, c, koff;
  __device__ __forceinline__ void init(int mode_, const void* A_, const void* B_, int lda_, int ldb_, int M, int N, int koff_) {
    mode = mode_; A = (const char*)A_; B = (const char*)B_; lda = lda_; ldb = ldb_; nM = M / BM; nN = N / BM; nwg = nM * nN; G = (int)GDIM(); c = (int)BIDX(); koff = koff_;
  }
  __device__ __forceinline__ bool next(int i, Unit& u) const {
    const long Lq = (long)i * G + c; if (Lq >= nwg) return false;
    int wgid = (int)Lq;
    if (mode == 0) {
      { const int q = nwg / NXCD, r = nwg % NXCD, xcd = wgid % NXCD, off = wgid / NXCD; wgid = (xcd < r ? xcd * (q + 1) : r * (q + 1) + (xcd - r) * q) + off; }
      const int nig = WGM * nN, gid = wgid / nig, fm = gid * WGM, gsz = (nM - fm) < WGM ? (nM - fm) : WGM;
      u.pm = fm + ((wgid % nig) % gsz); u.pn = (wgid % nig) / gsz;
      u.a = A + ((size_t)u.pm * BM * lda + koff) * 2; u.b = B + ((size_t)u.pn * BM * ldb + koff) * 2;
    } else if (mode == 1) {
      const int b = wgid >> 6, h = (wgid >> 4) & 3, qt = wgid & 15;
      u.pm = b * 16 + qt; u.pn = h;
      u.a = A + ((size_t)(b * 4096 + qt * 256) * 2048 + h * 512) * 2; u.b = B + ((size_t)(b * 256) * 2048 + h * 512) * 2;
    } else if (mode == 2) {
      const int dt = wgid & 1, qt = (wgid >> 1) & 15, h = (wgid >> 5) & 3, b = wgid >> 7;
      u.pm = b * 16 + qt; u.pn = h * 2 + dt;
      u.a = A + ((size_t)(b * 4096 + qt * 256) * 1024 + h * 256) * 2; u.b = B + ((size_t)(h * 512 + dt * 256) * 1024 + b * 256) * 2;
    } else {
      const int x = wgid & 7, j = wgid >> 3, b = x >> 1, s = x & 1, kt = j >> 1, mt = j & 1;
      u.pm = b * 16 + kt; u.pn = 4 + s * 2 + mt;
      u.a = A + ((size_t)(kt * 256) * 8192 + s * 4096) * 2; u.b = B + ((size_t)(b * 512 + mt * 256) * 8192 + s * 4096) * 2;
    }
    return true;
  }
};

typedef int i32x4v __attribute__((ext_vector_type(4)));
typedef int i32x8v __attribute__((ext_vector_type(8)));
template <class Epi, bool F8 = false>
__device__ __forceinline__ void gemm_phase(LAS unsigned char* lds, const Sched& S, int nt, const Epi& E) {
    int tid = TIDX(); asm volatile("" : "+v"(tid));
    const int wid = __builtin_amdgcn_readfirstlane(tid >> 6), lane = tid & 63, wr = wid >> 2, wc = wid & 3, fr = lane & 15, fq = lane >> 4;
    unsigned voffA[1], voffB[1];
    { int R, C; stage_rc(tid * 16, R, C); const int Rb = Epi::PERM ? ((R & ~31) + perm32(R & 31)) : R;
        voffA[0] = (unsigned)(R * S.lda + C) * 2u; voffB[0] = (unsigned)(Rb * S.ldb + C) * 2u; }
    const size_t qstepA = (size_t)64 * S.lda * 2, qstepB = (size_t)64 * S.ldb * 2;
    const size_t kstep = (size_t)(BK * 2);
    const size_t hstepA = (size_t)HALF * S.lda * 2, hstepB = (size_t)HALF * S.ldb * 2;
    const unsigned ldsw = (unsigned)wid * 1024u;
    const int aoff = lds_byte(wr * 64 + fr, fq * 8), boff = lds_byte(wc * 32 + fr, fq * 8);
#define PG8_SA(b, h) (((b) * 2 + (h)) * HTB)
#define PG8_SB(b, h) ((4 + (b) * 2 + (h)) * HTB)
#define PG8_STAGE(bufoff, gbase, voff) do { _Pragma("unroll") for (int _i = 0; _i < 2; ++_i) \
        __builtin_amdgcn_global_load_lds((const unsigned*)((const char*)(gbase) + (size_t)_i * q##voff + (voff)[0]), (LAS unsigned*)(lds + (bufoff) + ldsw + _i * 8192), 16, 0, 0); } while (0)
#define qvoffA qstepA
#define qvoffB qstepB
#define PG8_LDA(dst, b, h) do { if constexpr (F8) { _Pragma("unroll") for (int m = 0; m < 4; ++m) dst##8[m] = __builtin_shufflevector(*(const LAS i32x4v*)(lds + PG8_SA(b, h) + aoff + m * 2048), *(const LAS i32x4v*)(lds + PG8_SA(b, h) + aoff + m * 2048 + 1024), 0, 1, 2, 3, 4, 5, 6, 7); } \
        else { _Pragma("unroll") for (int m = 0; m < 4; ++m) _Pragma("unroll") for (int k = 0; k < 2; ++k) dst[m][k] = *(const LAS bf16x8*)(lds + PG8_SA(b, h) + aoff + m * 2048 + k * 1024); } } while (0)
#define PG8_LDB(dst, b, h) do { if constexpr (F8) { _Pragma("unroll") for (int n = 0; n < 2; ++n) dst##8[n] = __builtin_shufflevector(*(const LAS i32x4v*)(lds + PG8_SB(b, h) + boff + n * 2048), *(const LAS i32x4v*)(lds + PG8_SB(b, h) + boff + n * 2048 + 1024), 0, 1, 2, 3, 4, 5, 6, 7); } \
        else { _Pragma("unroll") for (int n = 0; n < 2; ++n) _Pragma("unroll") for (int k = 0; k < 2; ++k) dst[n][k] = *(const LAS bf16x8*)(lds + PG8_SB(b, h) + boff + n * 2048 + k * 1024); } } while (0)
#define PG8_MMA(ai, bj, At, Bt) do { __builtin_amdgcn_s_setprio(1); \
        if constexpr (F8) { _Pragma("unroll") for (int m = 0; m < 4; ++m) _Pragma("unroll") for (int n = 0; n < 2; ++n) \
            asm volatile("v_mfma_scale_f32_16x16x128_f8f6f4 %0, %1, %2, %0, %3, %3 op_sel_hi:[0,0,0]" : "+v"(acc[ai][bj][m][n]) : "v"(Bt##8[n]), "v"(At##8[m]), "v"(f8scale)); } \
        else { _Pragma("unroll") for (int m = 0; m < 4; ++m) _Pragma("unroll") for (int n = 0; n < 2; ++n) _Pragma("unroll") for (int k = 0; k < 2; ++k) \
            acc[ai][bj][m][n] = __builtin_amdgcn_mfma_f32_16x16x32_bf16(Bt[n][k], At[m][k], acc[ai][bj][m][n], 0, 0, 0); } \
        __builtin_amdgcn_s_setprio(0); } while (0)
#define PG8_WAIT_V(n) asm volatile("s_waitcnt vmcnt(" #n ")" ::: "memory")
#define PG8_WAIT_L(n) asm volatile("s_waitcnt lgkmcnt(" #n ")" ::: "memory")
#define PG8_BAR __builtin_amdgcn_s_barrier()
#define PG8_SCHED __builtin_amdgcn_sched_barrier(0)
    Unit cur, nxt; int ui = 0;
    if (!S.next(0, cur)) return;
    f32x4 acc[2][2][4][2];
#pragma unroll
    for (int a = 0; a < 2; ++a)
#pragma unroll
        for (int b = 0; b < 2; ++b)
#pragma unroll
            for (int m = 0; m < 4; ++m)
#pragma unroll
                for (int n = 0; n < 2; ++n) acc[a][b][m][n] = (f32x4){0.f, 0.f, 0.f, 0.f};
    bf16x8 At[4][2], B0[2][2], B1[2][2]; i32x8v At8[4], B08[2], B18[2]; const int f8scale = 0x7f7f7f7f;
    const char* cA = cur.a; const char* cB = cur.b;
    PG8_STAGE(PG8_SB(0, 0), cB, voffB); PG8_STAGE(PG8_SA(0, 0), cA, voffA); PG8_STAGE(PG8_SB(0, 1), cB + hstepB, voffB); PG8_STAGE(PG8_SA(0, 1), cA + hstepA, voffA);
    if (wr == 1) PG8_BAR;
    PG8_WAIT_V(4); PG8_BAR;
    PG8_STAGE(PG8_SB(1, 0), cB + kstep, voffB); PG8_STAGE(PG8_SA(1, 0), cA + kstep, voffA); PG8_STAGE(PG8_SB(1, 1), cB + hstepB + kstep, voffB);
    PG8_WAIT_V(6); PG8_BAR;
    for (;;) {
        const bool has_next = S.next(ui + 1, nxt);
        const char* nA = has_next ? nxt.a : cA; const char* nB = has_next ? nxt.b : cB;
        for (int t = 0; t < nt; t += 2) {
            const bool last = (t == nt - 2);
            const char* a1 = cA + (size_t)(t + 1) * kstep;
            const char* a2 = last ? nA : cA + (size_t)(t + 2) * kstep; const char* b2 = last ? nB : cB + (size_t)(t + 2) * kstep;
            const char* a3 = a2 + kstep; const char* b3 = b2 + kstep;
            PG8_LDB(B0, 0, 0); PG8_SCHED; PG8_LDA(At, 0, 0); PG8_STAGE(PG8_SA(1, 1), a1 + hstepA, voffA);
            PG8_WAIT_L(8); PG8_BAR; PG8_WAIT_L(0); PG8_MMA(0, 0, At, B0); PG8_BAR; PG8_SCHED;
            PG8_LDB(B1, 0, 1); PG8_STAGE(PG8_SB(0, 0), b2, voffB);
            PG8_BAR; PG8_WAIT_L(0); PG8_MMA(0, 1, At, B1); PG8_BAR;
            PG8_LDA(At, 0, 1); PG8_STAGE(PG8_SA(0, 0), a2, voffA);
            PG8_BAR; PG8_WAIT_L(0); PG8_MMA(1, 0, At, B0); PG8_BAR; PG8_SCHED;
            PG8_STAGE(PG8_SB(0, 1), b2 + hstepB, voffB);
            PG8_WAIT_V(6); PG8_BAR; PG8_MMA(1, 1, At, B1); PG8_BAR;
            PG8_LDB(B0, 1, 0); PG8_SCHED; PG8_LDA(At, 1, 0); PG8_STAGE(PG8_SA(0, 1), a2 + hstepA, voffA);
            PG8_WAIT_L(8); PG8_BAR; PG8_WAIT_L(0); PG8_MMA(0, 0, At, B0); PG8_BAR; PG8_SCHED;
            PG8_LDB(B1, 1, 1); PG8_STAGE(PG8_SB(1, 0), b3, voffB);
            PG8_BAR; PG8_WAIT_L(0); PG8_MMA(0, 1, At, B1); PG8_BAR;
            PG8_LDA(At, 1, 1); PG8_STAGE(PG8_SA(1, 0), a3, voffA);
            PG8_BAR; PG8_WAIT_L(0); PG8_MMA(1, 0, At, B0); PG8_BAR; PG8_SCHED;
            PG8_STAGE(PG8_SB(1, 1), b3 + hstepB, voffB);
            PG8_WAIT_V(6); PG8_BAR; PG8_MMA(1, 1, At, B1); PG8_BAR;
        }
        if constexpr (F8) { asm volatile("s_nop 15\n\ts_nop 15\n\ts_nop 15\n\ts_nop 15" ::: "memory"); }
        if constexpr (!Epi::AFTER_DRAIN) { E(acc, cur, wr, wc, fr, fq); }
        if (!has_next) break;
#pragma unroll
        for (int a = 0; a < 2; ++a)
#pragma unroll
            for (int b = 0; b < 2; ++b)
#pragma unroll
                for (int m = 0; m < 4; ++m)
#pragma unroll
                    for (int n = 0; n < 2; ++n) acc[a][b][m][n] = (f32x4){0.f, 0.f, 0.f, 0.f};
        cur = nxt; cA = nA; cB = nB; ++ui;
    }
    PG8_WAIT_V(0);
    if (wr == 0) PG8_BAR;
    PG8_BAR;
    if constexpr (Epi::AFTER_DRAIN) { E.fused(acc, cur, wr, wc, fr, fq, lds, wid, lane); }
#undef PG8_SA
#undef PG8_SB
#undef PG8_STAGE
#undef qvoffA
#undef qvoffB
#undef PG8_LDA
#undef PG8_LDB
#undef PG8_MMA
#undef PG8_WAIT_V
#undef PG8_WAIT_L
#undef PG8_BAR
#undef PG8_SCHED
}

typedef f32x4 Acc[2][2][4][2];

struct EpiSwiGLU {
  static constexpr bool PERM = true, AFTER_DRAIN = false;
  bf16_t* H; const float* rs; float cscale; int h8;
  __device__ __forceinline__ void operator()(const Acc& acc, const Unit& u, int wr_, int wc_, int fr_, int fq_) const {
    const int tid_ = TIDX(), lane_ = tid_ & 63, wid_ = tid_ >> 6, wr = wid_ >> 2, wc = wid_ & 3, fr = lane_ & 15, fq = lane_ >> 4;
    const int row0 = u.pm * BM + wr * 64 + fr, col0 = u.pn * 128 + wc * 32 + 8 * fq;
#pragma unroll
    for (int ai = 0; ai < 2; ++ai)
#pragma unroll
      for (int m = 0; m < 4; ++m) {
        const int row = row0 + ai * HALF + m * 16; const float r = rs ? rs[row] : cscale;
        float o[8];
#pragma unroll
        for (int n = 0; n < 2; ++n)
#pragma unroll
          for (int j = 0; j < 4; ++j) { const float g = acc[ai][0][m][n][j] * r, up = acc[ai][1][m][n][j] * r; o[n * 4 + j] = g * up * __builtin_amdgcn_rcpf(1.0f + __builtin_amdgcn_exp2f(g * -1.4426950408889634f)); }
        if (h8) { u32x2 w; w.x = cvt4_fp8(o[0] * F8_SH, o[1] * F8_SH, o[2] * F8_SH, o[3] * F8_SH); w.y = cvt4_fp8(o[4] * F8_SH, o[5] * F8_SH, o[6] * F8_SH, o[7] * F8_SH); *(u32x2*)((unsigned char*)H + (size_t)row * DFF + col0) = w; }
        else { u32x4 w; w.x = cvt_pk_bf16(o[0], o[1]); w.y = cvt_pk_bf16(o[2], o[3]); w.z = cvt_pk_bf16(o[4], o[5]); w.w = cvt_pk_bf16(o[6], o[7]);
        *(u32x4*)(H + (size_t)row * DFF + col0) = w; }
      }
  }
};
struct EpiY {
  static constexpr bool PERM = true, AFTER_DRAIN = false;
  bf16_t* Y; float* part; float cs;
  __device__ __forceinline__ void operator()(const Acc& acc, const Unit& u, int wr, int wc, int fr, int fq) const {
    const int row0 = u.pm * BM + wr * 64 + fr, col0 = u.pn * BM + wc * 32 + 8 * fq;
#pragma unroll
    for (int ai = 0; ai < 2; ++ai)
#pragma unroll
      for (int m = 0; m < 4; ++m) {
        const int row = row0 + ai * HALF + m * 16; bf16_t* rowp = Y + (size_t)row * DM + col0; float s = 0.f;
#pragma unroll
        for (int bj = 0; bj < 2; ++bj) {
          const f32x4 v0 = acc[ai][bj][m][0] * cs, v1 = acc[ai][bj][m][1] * cs;
          s += (v0[0] * v0[0] + v0[1] * v0[1]) + (v0[2] * v0[2] + v0[3] * v0[3]) + (v1[0] * v1[0] + v1[1] * v1[1]) + (v1[2] * v1[2] + v1[3] * v1[3]);
          u32x4 w; w.x = cvt_pk_bf16(v0[0], v0[1]); w.y = cvt_pk_bf16(v0[2], v0[3]); w.z = cvt_pk_bf16(v1[0], v1[1]); w.w = cvt_pk_bf16(v1[2], v1[3]);
          *(u32x4*)(rowp + bj * HALF) = w;
        }
        s += shfl_xor_f(s, 16); s += shfl_xor_f(s, 32);
        if (fq == 0) part[(size_t)row * 32 + u.pn * 4 + wc] = s;
      }
  }
};
struct EpiRowBf16 {
  static constexpr bool PERM = true, AFTER_DRAIN = false;
  bf16_t* O; int ldc; const float* rs; int act, actcol0;
  __device__ __forceinline__ void operator()(const Acc& acc, const Unit& u, int wr, int wc, int fr, int fq) const {
    const int row0 = u.pm * BM + wr * 64 + fr, col0 = u.pn * BM + wc * 32 + 8 * fq;
    const bool sg = act && (u.pn * BM >= actcol0);
#pragma unroll
    for (int ai = 0; ai < 2; ++ai)
#pragma unroll
      for (int m = 0; m < 4; ++m) {
        const int row = row0 + ai * HALF + m * 16; const float r = rs ? rs[row] : 1.0f; bf16_t* rowp = O + (size_t)row * ldc + col0;
#pragma unroll
        for (int bj = 0; bj < 2; ++bj) {
          f32x4 v0 = acc[ai][bj][m][0] * r, v1 = acc[ai][bj][m][1] * r;
          if (sg) {
#pragma unroll
            for (int j = 0; j < 4; ++j) { v0[j] = __builtin_amdgcn_rcpf(1.0f + __builtin_amdgcn_exp2f(v0[j] * -1.4426950408889634f)); v1[j] = __builtin_amdgcn_rcpf(1.0f + __builtin_amdgcn_exp2f(v1[j] * -1.4426950408889634f)); }
          }
          u32x4 w; w.x = cvt_pk_bf16(v0[0], v0[1]); w.y = cvt_pk_bf16(v0[2], v0[3]); w.z = cvt_pk_bf16(v1[0], v1[1]); w.w = cvt_pk_bf16(v1[2], v1[3]);
          *(u32x4*)(rowp + bj * HALF) = w;
        }
      }
  }
};
struct EpiColBf16 {
  static constexpr bool PERM = true, AFTER_DRAIN = false;
  bf16_t* O; const float* cs; int mode;
  __device__ __forceinline__ void operator()(const Acc& acc, const Unit& u, int wr, int wc, int fr, int fq) const {
    const int row0 = u.pm * BM + wr * 64 + fr, col0 = u.pn * BM + wc * 32 + 8 * fq;
    f32x4 sc[2][2];
#pragma unroll
    for (int bj = 0; bj < 2; ++bj)
#pragma unroll
      for (int n = 0; n < 2; ++n) sc[bj][n] = *(const f32x4*)(cs + col0 + bj * HALF + 4 * n);
#pragma unroll
    for (int ai = 0; ai < 2; ++ai)
#pragma unroll
      for (int m = 0; m < 4; ++m) {
        const int row = row0 + ai * HALF + m * 16;
#pragma unroll
        for (int bj = 0; bj < 2; ++bj) {
          const int col = col0 + bj * HALF;
          size_t off;
          if (mode == 0) off = (size_t)row * 1024 + col;
          else if (row < 3072) off = (size_t)row * NTOK + col;
          else { const int rr = row - 3072, s = rr >> 9, mm = rr & 511, b = col >> 12, l = col & 4095; off = (size_t)3072 * NTOK + ((size_t)((b * 512 + mm) * 2 + s)) * 4096 + l; }
          const f32x4 v0 = acc[ai][bj][m][0] * sc[bj][0], v1 = acc[ai][bj][m][1] * sc[bj][1];
          u32x4 w; w.x = cvt_pk_bf16(v0[0], v0[1]); w.y = cvt_pk_bf16(v0[2], v0[3]); w.z = cvt_pk_bf16(v1[0], v1[1]); w.w = cvt_pk_bf16(v1[2], v1[3]);
          *(u32x4*)(O + off) = w;
        }
      }
  }
};
struct EpiFilt {
  static constexpr bool PERM = false, AFTER_DRAIN = false;
  float* TS;
  __device__ __forceinline__ void operator()(const Acc& acc, const Unit& u, int wr, int wc, int fr, int fq) const {
    const int row0 = u.pm * BM + wr * 64 + fr, col0 = u.pn * BM + wc * 32 + 4 * fq;
    const float min_decay = -3.0701134573f, max_decay = -15.3505672866f;
#pragma unroll
    for (int ai = 0; ai < 2; ++ai)
#pragma unroll
      for (int m = 0; m < 4; ++m) {
        const int row = row0 + ai * HALF + m * 16, ch = row & 1023, dir = (row >> 10) & 1, o = row >> 11;
        const float dl = fabsf(min_decay + (float)ch * ((max_decay - min_decay) / 1023.0f)) * (-1.4426950408889634f / (float)(SEQ - 1));
        float* dst = TS + (size_t)(o * 1024 + ch) * 8192;
#pragma unroll
        for (int bj = 0; bj < 2; ++bj)
#pragma unroll
          for (int n = 0; n < 2; ++n) {
            const int pos = col0 + bj * HALF + n * 16; f32x4 v;
#pragma unroll
            for (int j = 0; j < 4; ++j) v[j] = acc[ai][bj][m][n][j] * __builtin_amdgcn_exp2f((float)(pos + j) * dl) * (1.0f / 8192.0f);
            if (dir == 0) *(f32x4*)(dst + pos) = v;
            else if (pos != 0) { const f32x4 r = {v[3], v[2], v[1], v[0]}; *(f32x4*)(dst + 8192 - pos - 3) = r; }
            else { dst[4096] = 0.f; dst[8191] = v[1]; dst[8190] = v[2]; dst[8189] = v[3]; }
          }
      }
  }
};
template <int W> struct EpiMerge {
  static constexpr bool PERM = false, AFTER_DRAIN = false;
  float* MF; bf16_t* MB; const bf16_t* PN;
  __device__ __forceinline__ void operator()(const Acc& acc, const Unit& u, int wr, int wc, int fr, int fq) const {
    const int row0 = u.pm * BM + wr * 64 + fr, col0 = u.pn * BM + wc * 32 + 4 * fq;
#pragma unroll
    for (int ai = 0; ai < 2; ++ai)
#pragma unroll
      for (int m = 0; m < 4; ++m) {
        const int row = row0 + ai * HALF + m * 16;
#pragma unroll
        for (int bj = 0; bj < 2; ++bj)
#pragma unroll
          for (int n = 0; n < 2; ++n) {
            const int col = col0 + bj * HALF + n * 16;
            const u32x2 gw = *(const u32x2*)(PN + (size_t)row * 6656 + 512 + W * 2048 + col);
            f32x4 g; g[0] = bf2f(gw.x & 0xffffu); g[1] = bf2f(gw.x >> 16); g[2] = bf2f(gw.y & 0xffffu); g[3] = bf2f(gw.y >> 16);
            f32x4 v = acc[ai][bj][m][n] * g;
            float* mp = MF + (size_t)row * DM + col;
            if (W > 0) v += *(const f32x4*)mp;
            if (W < 2) *(f32x4*)mp = v;
            else { u32x2 w; w.x = cvt_pk_bf16(v[0], v[1]); w.y = cvt_pk_bf16(v[2], v[3]); *(u32x2*)(MB + (size_t)row * DM + col) = w; }
          }
      }
  }
};
struct EpiSoftmax {
  static constexpr bool PERM = true, AFTER_DRAIN = true;
  bf16_t* P; float scale_log2e;
  __device__ __forceinline__ void fused(Acc& acc, const Unit& u, int wr, int wc, int fr, int fq, LAS unsigned char* lds, int wid, int lane) const {
    LAS float* RM = (LAS float*)lds;
    LAS float* RS = (LAS float*)(lds + 4096);
    float mx[2][4];
#pragma unroll
    for (int ai = 0; ai < 2; ++ai)
#pragma unroll
      for (int m = 0; m < 4; ++m) {
        float v = -3.0e38f;
#pragma unroll
        for (int bj = 0; bj < 2; ++bj)
#pragma unroll
          for (int n = 0; n < 2; ++n)
#pragma unroll
            for (int j = 0; j < 4; ++j) v = fmaxf(v, acc[ai][bj][m][n][j]);
        v = fmaxf(v, shfl_xor_f(v, 16)); v = fmaxf(v, shfl_xor_f(v, 32));
        if (fq == 0) RM[(ai * HALF + wr * 64 + m * 16 + fr) * 4 + wc] = v;
      }
    __syncthreads();
#pragma unroll
    for (int ai = 0; ai < 2; ++ai)
#pragma unroll
      for (int m = 0; m < 4; ++m) {
        const int r = ai * HALF + wr * 64 + m * 16 + fr;
        const f32x4 q = *(const LAS f32x4*)(RM + r * 4);
        const float mxx = fmaxf(fmaxf(q[0], q[1]), fmaxf(q[2], q[3]));
        float s = 0.f;
#pragma unroll
        for (int bj = 0; bj < 2; ++bj)
#pragma unroll
          for (int n = 0; n < 2; ++n)
#pragma unroll
            for (int j = 0; j < 4; ++j) { const float e = __builtin_amdgcn_exp2f((acc[ai][bj][m][n][j] - mxx) * scale_log2e); acc[ai][bj][m][n][j] = e; s += e; }
        s += shfl_xor_f(s, 16); s += shfl_xor_f(s, 32);
        if (fq == 0) RS[r * 4 + wc] = s;
        mx[ai][m] = 0.f;
      }
    __syncthreads();
    const int row0 = u.pm * BM + wr * 64 + fr, col0 = u.pn * BM + wc * 32 + 8 * fq;
#pragma unroll
    for (int ai = 0; ai < 2; ++ai)
#pragma unroll
      for (int m = 0; m < 4; ++m) {
        const int r = ai * HALF + wr * 64 + m * 16 + fr;
        const f32x4 q = *(const LAS f32x4*)(RS + r * 4);
        const float inv = 1.0f / ((q[0] + q[1]) + (q[2] + q[3]) + mx[ai][m]);
        bf16_t* rowp = P + (size_t)(row0 + ai * HALF + m * 16) * 1024 + col0;
#pragma unroll
        for (int bj = 0; bj < 2; ++bj) {
          const f32x4 v0 = acc[ai][bj][m][0] * inv, v1 = acc[ai][bj][m][1] * inv;
          u32x4 w; w.x = cvt_pk_bf16(v0[0], v0[1]); w.y = cvt_pk_bf16(v0[2], v0[3]); w.z = cvt_pk_bf16(v1[0], v1[1]); w.w = cvt_pk_bf16(v1[2], v1[3]);
          *(u32x4*)(rowp + bj * HALF) = w;
        }
      }
    __syncthreads();
  }
};
}

__device__ __forceinline__ const float* inl(KP p, int i, int l) { return p->in[i] + (size_t)l * p->lsz[i]; }

struct CJob { const float* src; const float* gain; bf16_t* dst; int K, N, lds_, ldd, koff, col0, mode, f8; };
__device__ __forceinline__ bool get_job(KP p, int l, int j, CJob& J) {
  bf16_t* wb = (bf16_t*)p->ws;
  J.gain = nullptr; J.koff = 0; J.col0 = 0; J.mode = 0; J.f8 = 0;
  switch (j) {
    case 0: J.src = inl(p, 3, l); J.gain = inl(p, 2, l); J.dst = wb + O_WGU1 / 2; J.K = 2048; J.N = 11264; J.lds_ = 11264; J.ldd = 2048; J.mode = 1; J.f8 = (l == 1); break;
    case 1: J.src = inl(p, 4, l); J.dst = wb + O_WD1 / 2; J.K = 5632; J.N = 2048; J.lds_ = 2048; J.ldd = 5632; break;
    case 2: J.src = inl(p, 7, l); J.gain = inl(p, 6, l); J.dst = wb + O_WINT / 2; J.K = 2048; J.N = 3072; J.lds_ = 10240; J.ldd = 2048; break;
    case 3: J.src = inl(p, 7, l); J.gain = inl(p, 6, l); J.dst = wb + O_WINN / 2; J.K = 2048; J.N = 6656; J.lds_ = 10240; J.ldd = 2048; J.col0 = 3584; break;
    case 4: J.src = inl(p, 19, l); J.dst = wb + O_WM / 2; J.K = 1024; J.N = 2048; J.lds_ = 2048; J.ldd = 2560; break;
    case 5: J.src = inl(p, 20, l); J.dst = wb + O_WM / 2; J.K = 512; J.N = 2048; J.lds_ = 2048; J.ldd = 2560; J.koff = 1024; break;
    case 6: J.src = inl(p, 20, l); J.dst = wb + O_WM / 2; J.K = 512; J.N = 2048; J.lds_ = 2048; J.ldd = 2560; J.koff = 1536; break;
    case 7: J.src = inl(p, 23, l); J.dst = wb + O_WOUT / 2; J.K = 2048; J.N = 2048; J.lds_ = 2048; J.ldd = 2048; break;
    case 8: J.src = inl(p, 27, l); J.gain = inl(p, 25, l); J.dst = wb + O_WQ / 2; J.K = 2048; J.N = 2048; J.lds_ = 2048; J.ldd = 2048; break;
    case 9: J.src = inl(p, 28, l); J.gain = inl(p, 26, l); J.dst = wb + O_WK / 2; J.K = 2048; J.N = 2048; J.lds_ = 4096; J.ldd = 2048; break;
    case 10: J.src = inl(p, 28, l); J.gain = inl(p, 26, l); J.dst = wb + O_WV / 2; J.K = 2048; J.N = 2048; J.lds_ = 4096; J.ldd = 2048; J.col0 = 2048; break;
    case 11: J.src = inl(p, 29, l); J.dst = wb + O_WO / 2; J.K = 2048; J.N = 2048; J.lds_ = 2048; J.ldd = 2048; break;
    case 12: J.src = inl(p, 32, l); J.gain = inl(p, 31, l); J.dst = wb + O_WGU2 / 2; J.K = 2048; J.N = 11264; J.lds_ = 11264; J.ldd = 2048; J.mode = 1; J.f8 = (l == 1); break;
    case 13: J.src = inl(p, 33, l); J.dst = wb + O_WD2 / 2; J.K = 5632; J.N = 2048; J.lds_ = 2048; J.ldd = 5632; J.f8 = (l == 1); break;
    case 14: J.src = inl(p, 16, l); J.dst = (bf16_t*)(p->ws + O_W4T); J.K = 64; J.N = 4096; J.lds_ = 4096; J.ldd = 256; break;
    default: return false;
  }
  return true;
}

__device__ __forceinline__ void phase_conv(KP p, int l, float* ldsf) {
  const int tid = TIDX();
  {
    int buf = 0;
    const int r = tid >> 5, c4 = (tid & 31) * 4;
    for (int j = 0; j < 15; ++j) {
      CJob J; get_job(p, l, j, J);
      const int nkt = J.K / 64, ntile = nkt * (J.N / 128);
      const float gsc = J.f8 ? F8_SW : 1.0f;
      auto load_tile = [&](f32x4 (&v)[4], int t) {
        const int kt = t % nkt, ntl = t / nkt, k0 = kt * 64, n0 = ntl * 128;
        int scol; if (J.mode == 1) { const int tt = n0 >> 8, h = (n0 >> 7) & 1; scol = h * DFF + tt * 128; } else scol = J.col0 + n0;
        const float* sp = J.src + (size_t)(k0 + r) * J.lds_ + scol + c4;
#pragma unroll
        for (int q = 0; q < 4; ++q) v[q] = __builtin_nontemporal_load((const f32x4*)(sp + (size_t)(16 * q) * J.lds_)); };
      auto process_tile = [&](f32x4 (&v)[4], int t) {
        float* T = ldsf + buf * (64 * 129);
        const int kt = t % nkt, ntl = t / nkt, k0 = kt * 64, n0 = ntl * 128;
#pragma unroll
        for (int q = 0; q < 4; ++q) { const float g = (J.gain ? J.gain[k0 + r + 16 * q] : 1.0f) * gsc; float* d = T + (r + 16 * q) * 129 + c4; d[0] = v[q][0] * g; d[1] = v[q][1] * g; d[2] = v[q][2] * g; d[3] = v[q][3] * g; }
        __syncthreads();
        if (J.f8) {
          const int n = tid >> 2, kc = (tid & 3) * 16;
          float o[16];
#pragma unroll
          for (int i = 0; i < 16; ++i) o[i] = T[(kc + i) * 129 + n];
          u32x4 w; w.x = cvt4_fp8(o[0], o[1], o[2], o[3]); w.y = cvt4_fp8(o[4], o[5], o[6], o[7]); w.z = cvt4_fp8(o[8], o[9], o[10], o[11]); w.w = cvt4_fp8(o[12], o[13], o[14], o[15]);
          *(u32x4*)((unsigned char*)J.dst + (size_t)(n0 + n) * J.ldd + k0 + kc) = w;
        } else {
#pragma unroll
          for (int h = 0; h < 2; ++h) {
            const int id = tid + 512 * h, n = id >> 3, kc = (id & 7) * 8;
            float o[8];
#pragma unroll
            for (int i = 0; i < 8; ++i) o[i] = T[(kc + i) * 129 + n];
            u32x4 w; w.x = cvt_pk_bf16(o[0], o[1]); w.y = cvt_pk_bf16(o[2], o[3]); w.z = cvt_pk_bf16(o[4], o[5]); w.w = cvt_pk_bf16(o[6], o[7]);
            *(u32x4*)(J.dst + (size_t)(n0 + n) * J.ldd + J.koff + k0 + kc) = w;
          }
        }
        buf ^= 1; };
      f32x4 va[4], vb[4];
      int t = BIDX();
      if (t < ntile) load_tile(va, t);
      while (t < ntile) {
        int tn = t + GDIM();
        if (tn < ntile) load_tile(vb, tn);
        process_tile(va, t);
        t = tn; if (t >= ntile) break;
        tn = t + GDIM();
        if (tn < ntile) load_tile(va, tn);
        process_tile(vb, t);
        t = tn;
      }
    }
    __syncthreads();
  }
  {
    const float* win = inl(p, 7, l); const float* gain = inl(p, 6, l); bf16_t* dst = (bf16_t*)p->ws + O_WINT / 2;
    float* tile = ldsf;
    float* ctab = ldsf + 64 * 129;
    if (tid < 128) { const float rv = (float)tid * (1.0f / 128.0f); ctab[tid] = __builtin_amdgcn_cosf(rv); ctab[128 + tid] = __builtin_amdgcn_sinf(rv); }
    const float scale = 0.0013810679f;
    for (int t = BIDX(); t < 256; t += GDIM()) {
      const int kt = t >> 3, g = (t >> 1) & 3, mh = t & 1, k0 = kt * 64;
      __syncthreads();
      for (int e = tid; e < 64 * 32; e += 512) { const int rr = e >> 5, c4 = (e & 31) * 4; const f32x4 v = *(const f32x4*)(win + (size_t)(k0 + rr) * 10240 + 3072 + g * 128 + c4);
        tile[rr * 129 + c4 + 0] = v[0]; tile[rr * 129 + c4 + 1] = v[1]; tile[rr * 129 + c4 + 2] = v[2]; tile[rr * 129 + c4 + 3] = v[3]; }
      __syncthreads();
      const int kk = tid & 63, mg = tid >> 6;
      float ac[8], as[8];
#pragma unroll
      for (int i = 0; i < 8; ++i) { ac[i] = 0.f; as[i] = 0.f; }
      for (int c = 0; c < 128; ++c) {
        const float x = tile[kk * 129 + c];
#pragma unroll
        for (int i = 0; i < 8; ++i) { const int m = mh * 64 + mg * 8 + i; const int ix = (m * c) & 127; ac[i] += x * ctab[ix]; as[i] += x * ctab[128 + ix]; }
      }
      const float gs = gain[k0 + kk] * scale;
#pragma unroll
      for (int i = 0; i < 8; ++i) { const int m = mh * 64 + mg * 8 + i;
        dst[(size_t)(3072 + g * 128 + m) * 2048 + k0 + kk] = f2bf(ac[i] * gs);
        dst[(size_t)(3072 + 512 + g * 128 + m) * 2048 + k0 + kk] = f2bf(as[i] * gs); }
    }
    __syncthreads();
  }
  {
    const float* wp = inl(p, 21, l); const float* ps = inl(p, 22, l); bf16_t* dst = (bf16_t*)p->ws + O_WM / 2;
    for (size_t e = (size_t)BIDX() * 512 + tid; e < (size_t)2048 * 512; e += (size_t)GDIM() * 512) {
      const int d = (int)(e >> 9), kk = (int)(e & 511), g = kk >> 7, c = kk & 127;
      float v = 0.f; if (g == (d >> 9)) v = wp[(size_t)(g * 128 + c) * 512 + (d & 511)] * ps[d];
      dst[(size_t)d * 2560 + 2048 + kk] = f2bf(v);
    }
    { bf16_t* w4t = (bf16_t*)(p->ws + O_W4T); bf16_t* hb = (bf16_t*)(p->ws + O_HIDB);
      for (size_t e = (size_t)BIDX() * 512 + tid; e < (size_t)4096 * 24; e += (size_t)GDIM() * 512) { const int n = (int)(e / 24), c8 = 64 + (int)(e % 24) * 8; const u32x4 z = {0u, 0u, 0u, 0u}; *(u32x4*)(w4t + (size_t)n * 256 + c8) = z; *(u32x4*)(hb + (size_t)n * 256 + c8) = z; } }
  }
}

__device__ __forceinline__ void phase_dftm(KP p, float* ldsf) {
  const int tid = TIDX();
  __syncthreads();
  for (int i = tid; i < 4096; i += 512) ldsf[i] = __builtin_amdgcn_cosf((float)i * (1.0f / 4096.0f));
  __syncthreads();
  bf16_t* D = (bf16_t*)(p->ws + O_DFTM);
  for (size_t e = (size_t)BIDX() * 512 + tid; e < (size_t)4096 * 1024; e += (size_t)GDIM() * 512) {
    const int k = (int)(e >> 10), j0 = (int)(e & 1023) * 8;
    float o[8];
#pragma unroll
    for (int i = 0; i < 8; ++i) { const int j = j0 + i;
      if (j < 4096) o[i] = ldsf[(k * j) & 4095]; else o[i] = -ldsf[((k * (j - 4096)) - 1024) & 4095]; }
    u32x4 w; w.x = cvt_pk_bf16(o[0], o[1]); w.y = cvt_pk_bf16(o[2], o[3]); w.z = cvt_pk_bf16(o[4], o[5]); w.w = cvt_pk_bf16(o[6], o[7]);
    *(u32x4*)(D + (size_t)k * 8192 + j0) = w;
  }
  __syncthreads();
}

__device__ __forceinline__ void phase_prep(KP p) {
  const int lane = TIDX() & 63, gw = (BIDX() * 512 + TIDX()) >> 6, nw = (GDIM() * 512) >> 6;
  for (int row = gw; row < NTOK + MEMROWS; row += nw) {
    const bool isx = row < NTOK; const int r = isx ? row : row - NTOK;
    const float* src = (isx ? p->in[0] : p->in[1]) + (size_t)r * DM;
    f32x4 v[8]; float ss = 0.f;
#pragma unroll
    for (int i = 0; i < 8; ++i) { v[i] = *(const f32x4*)(src + lane * 4 + i * 256); ss += (v[i][0] * v[i][0] + v[i][1] * v[i][1]) + (v[i][2] * v[i][2] + v[i][3] * v[i][3]); }
    ss = wave_sum(ss);
    const float rr = rsqrtf(ss * (1.0f / DM) + RMS_EPS);
    { bf16_t* dst = (bf16_t*)(p->ws + (isx ? O_XB : O_MB)) + (size_t)r * DM;
#pragma unroll
      for (int i = 0; i < 8; ++i) { u32x2 w; w.x = cvt_pk_bf16(v[i][0], v[i][1]); w.y = cvt_pk_bf16(v[i][2], v[i][3]); *(u32x2*)(dst + lane * 4 + i * 256) = w; }
    }
    if (lane == 0) ((float*)(p->ws + (isx ? O_RSTD : O_RSTDM)))[r] = rr;
  }
}

__device__ __forceinline__ void phase_resid(KP p, const float* xsrc, const float* gpost, float wgt, bool out8) {
  const int lane = TIDX() & 63, gw = (BIDX() * 512 + TIDX()) >> 6, nw = (GDIM() * 512) >> 6;
  const bf16_t* Y = (const bf16_t*)(p->ws + A_Y); const float* part = (const float*)(p->ws + O_PART);
  bf16_t* xb = (bf16_t*)(p->ws + O_XB); float* rstd = (float*)(p->ws + O_RSTD);
  for (int row0 = gw; row0 < NTOK; row0 += 2 * nw) {
    const int rowA = row0, rowB = row0 + nw;
    float psA = lane < 32 ? part[(size_t)rowA * 32 + lane] : 0.f, psB = lane < 32 ? part[(size_t)rowB * 32 + lane] : 0.f;
    u32x2 ya[8], yb[8]; f32x4 xa[8], xq[8];
#pragma unroll
    for (int i = 0; i < 8; ++i) { const int c = lane * 4 + i * 256; const size_t oa = (size_t)rowA * DM + c, ob = (size_t)rowB * DM + c;
      ya[i] = *(const u32x2*)(Y + oa); yb[i] = *(const u32x2*)(Y + ob); xa[i] = *(const f32x4*)(xsrc + oa); xq[i] = *(const f32x4*)(xsrc + ob); }
    psA = wave_sum(psA); psB = wave_sum(psB);
    const float rA = rsqrtf(psA * (1.0f / DM) + RMS_EPS) * wgt, rB = rsqrtf(psB * (1.0f / DM) + RMS_EPS) * wgt;
    float ssA = 0.f, ssB = 0.f;
#pragma unroll
    for (int i = 0; i < 8; ++i) { const int c = lane * 4 + i * 256; const f32x4 g = *(const f32x4*)(gpost + c);
      f32x4 y; y[0] = bf2f(ya[i].x & 0xffffu); y[1] = bf2f(ya[i].x >> 16); y[2] = bf2f(ya[i].y & 0xffffu); y[3] = bf2f(ya[i].y >> 16);
      xa[i] = xa[i] + y * g * rA; ssA += (xa[i][0] * xa[i][0] + xa[i][1] * xa[i][1]) + (xa[i][2] * xa[i][2] + xa[i][3] * xa[i][3]);
      y[0] = bf2f(yb[i].x & 0xffffu); y[1] = bf2f(yb[i].x >> 16); y[2] = bf2f(yb[i].y & 0xffffu); y[3] = bf2f(yb[i].y >> 16);
      xq[i] = xq[i] + y * g * rB; ssB += (xq[i][0] * xq[i][0] + xq[i][1] * xq[i][1]) + (xq[i][2] * xq[i][2] + xq[i][3] * xq[i][3]);
      *(f32x4*)(p->out + (size_t)rowA * DM + c) = xa[i]; *(f32x4*)(p->out + (size_t)rowB * DM + c) = xq[i]; }
    ssA = wave_sum(ssA); ssB = wave_sum(ssB);
    const float rrA = rsqrtf(ssA * (1.0f / DM) + RMS_EPS), rrB = rsqrtf(ssB * (1.0f / DM) + RMS_EPS);
    if (out8) {
      unsigned* dA = (unsigned*)(p->ws + O_XB8 + (size_t)rowA * DM); unsigned* dB = (unsigned*)(p->ws + O_XB8 + (size_t)rowB * DM); const float qa = rrA * F8_SA, qb = rrB * F8_SA;
#pragma unroll
      for (int i = 0; i < 8; ++i) { dA[lane + i * 64] = cvt4_fp8(xa[i][0] * qa, xa[i][1] * qa, xa[i][2] * qa, xa[i][3] * qa); dB[lane + i * 64] = cvt4_fp8(xq[i][0] * qb, xq[i][1] * qb, xq[i][2] * qb, xq[i][3] * qb); }
    } else {
#pragma unroll
      for (int i = 0; i < 8; ++i) { u32x2 w; w.x = cvt_pk_bf16(xa[i][0], xa[i][1]); w.y = cvt_pk_bf16(xa[i][2], xa[i][3]); *(u32x2*)(xb + (size_t)rowA * DM + lane * 4 + i * 256) = w;
        w.x = cvt_pk_bf16(xq[i][0], xq[i][1]); w.y = cvt_pk_bf16(xq[i][2], xq[i][3]); *(u32x2*)(xb + (size_t)rowB * DM + lane * 4 + i * 256) = w; }
    }
    if (lane == 0) { rstd[rowA] = rrA; rstd[rowB] = rrB; }
  }
}

__device__ __forceinline__ void phase_hid(KP p, int l) {
  const int lane = TIDX() & 63, gw = (BIDX() * 512 + TIDX()) >> 6, nw = (GDIM() * 512) >> 6;
  const float* w1 = inl(p, 10, l); const float* b1 = inl(p, 11, l); const float* w2 = inl(p, 12, l); const float* b2 = inl(p, 13, l);
  const float* w3 = inl(p, 14, l); const float* b3 = inl(p, 15, l); const float* fq = inl(p, 17, l);
  const float f = fq[lane];
  for (int pos = gw; pos < SEQ; pos += nw) {
    float z = 0.f;
    if (lane == 0) z = (float)pos / (float)(SEQ - 1);
    else if (lane < 33) { const int j = (lane - 1) & 15; const float band = 1e-4f + (float)j * ((15.0f - 1e-4f) / 15.0f);
      const float rev = (float)pos * band * (1.0f / (float)SEQ); z = lane < 17 ? __builtin_amdgcn_cosf(rev) : -__builtin_amdgcn_sinf(rev); }
    float a = b1[lane];
    for (int i = 0; i < 33; ++i) a += __int_as_float(__builtin_amdgcn_readlane(__float_as_int(z), i)) * w1[i * 64 + lane];
    float h = __builtin_amdgcn_sinf(f * a * 0.15915494309189535f);
    a = b2[lane];
    for (int i = 0; i < 64; ++i) a += __int_as_float(__builtin_amdgcn_readlane(__float_as_int(h), i)) * w2[i * 64 + lane];
    h = __builtin_amdgcn_sinf(f * a * 0.15915494309189535f);
    a = b3[lane];
    for (int i = 0; i < 64; ++i) a += __int_as_float(__builtin_amdgcn_readlane(__float_as_int(h), i)) * w3[i * 64 + lane];
    h = __builtin_amdgcn_sinf(f * a * 0.15915494309189535f);
    ((bf16_t*)(p->ws + O_HIDB))[(size_t)pos * 256 + lane] = f2bf(h);
  }
}

__device__ __forceinline__ void phase_filt(KP p, int l, float* ldsf) {
  const int tid = TIDX();
  const float* hid = (const float*)(p->ws + O_HID); const float* fw4 = inl(p, 16, l);
  float* TS = (float*)(p->ws + A_MB16);
  const float min_decay = -3.0701134573f, max_decay = -15.3505672866f;
  for (int tile = BIDX(); tile < 128 * 8; tile += GDIM()) {
    const int pt = tile >> 3, ct = tile & 7, pos0 = pt * 32, col = ct * 512 + tid, q = col >> 10, ch = col & 1023, o = q >> 1, dir = q & 1;
    __syncthreads();
    for (int e = tid; e < 32 * 64; e += 512) ldsf[e] = hid[(size_t)pos0 * 64 + e];
    __syncthreads();
    float acc[32];
#pragma unroll
    for (int i = 0; i < 32; ++i) acc[i] = 0.f;
    for (int i = 0; i < 64; i += 4) {
      const float wa = fw4[(size_t)i * 4096 + col], wb = fw4[(size_t)(i + 1) * 4096 + col], wc = fw4[(size_t)(i + 2) * 4096 + col], wd = fw4[(size_t)(i + 3) * 4096 + col];
#pragma unroll
      for (int pp = 0; pp < 32; ++pp) { const f32x4 h = *(const f32x4*)(ldsf + pp * 64 + i); acc[pp] += h[0] * wa + h[1] * wb + h[2] * wc + h[3] * wd; }
    }
    const float delta = fabsf(min_decay + (float)ch * ((max_decay - min_decay) / 1023.0f));
    float* stage = ldsf + 2048;
#pragma unroll
    for (int pp = 0; pp < 32; ++pp) {
      const int pos = pos0 + pp;
      stage[tid * 33 + pp] = acc[pp] * __expf(-((float)pos / (float)(SEQ - 1)) * delta) * (1.0f / 8192.0f);
    }
    __syncthreads();
    const int jj = tid & 31;
#pragma unroll 4
    for (int it = 0; it < 32; ++it) {
      const int row = it * 16 + (tid >> 5), rcol = ct * 512 + row, rch = rcol & 1023;
      float* dst = TS + (size_t)(o * 1024 + rch) * 8192; const float val = stage[row * 33 + jj]; const int pos = pos0 + jj;
      if (dir == 0) dst[pos] = val; else if (pos == 0) dst[4096] = 0.f; else dst[8192 - pos] = val;
    }
  }
  __syncthreads();
}

__device__ __forceinline__ f32x2 cmul(f32x2 a, f32x2 b) { return (f32x2){a.x * b.x - a.y * b.y, a.x * b.y + a.y * b.x}; }
template <bool INV> __device__ __forceinline__ void dft4(f32x2& a, f32x2& b, f32x2& c, f32x2& d) {
  const f32x2 s0 = a + c, s1 = a - c, s2 = b + d, s3 = b - d;
  const f32x2 js3 = INV ? (f32x2){-s3.y, s3.x} : (f32x2){s3.y, -s3.x};
  a = s0 + s2; c = s0 - s2; b = s1 + js3; d = s1 - js3;
}
#define XI(k) ((((k) & 3) * 4) + ((k) >> 2))
template <bool INV> __device__ __forceinline__ void dft16(f32x2 (&v)[16]) {
#pragma unroll
  for (int b = 0; b < 4; ++b) dft4<INV>(v[b], v[4 + b], v[8 + b], v[12 + b]);
  const float C1 = 0.92387953251f, S1 = 0.38268343236f, R2 = 0.70710678118f;
  const f32x2 W1 = {C1, INV ? S1 : -S1}, W2 = {R2, INV ? R2 : -R2}, W3 = {S1, INV ? C1 : -C1}, W4 = {0.f, INV ? 1.f : -1.f}, W6 = {-R2, INV ? R2 : -R2}, W9 = {-C1, INV ? -S1 : S1};
  v[4 * 1 + 1] = cmul(v[4 * 1 + 1], W1); v[4 * 1 + 2] = cmul(v[4 * 1 + 2], W2); v[4 * 1 + 3] = cmul(v[4 * 1 + 3], W3);
  v[4 * 2 + 1] = cmul(v[4 * 2 + 1], W2); v[4 * 2 + 2] = cmul(v[4 * 2 + 2], W4); v[4 * 2 + 3] = cmul(v[4 * 2 + 3], W6);
  v[4 * 3 + 1] = cmul(v[4 * 3 + 1], W3); v[4 * 3 + 2] = cmul(v[4 * 3 + 2], W6); v[4 * 3 + 3] = cmul(v[4 * 3 + 3], W9);
#pragma unroll
  for (int c = 0; c < 4; ++c) dft4<INV>(v[4 * c + 0], v[4 * c + 1], v[4 * c + 2], v[4 * c + 3]);
}
__device__ __forceinline__ void twiddle16(f32x2 (&v)[16], f32x2 w) {
  asm volatile("" : "+v"(w.x), "+v"(w.y));
  const f32x2 w2 = cmul(w, w), w3 = cmul(w2, w), w4 = cmul(w2, w2), w5 = cmul(w4, w), w6 = cmul(w4, w2), w7 = cmul(w4, w3), w8 = cmul(w4, w4);
  v[XI(1)] = cmul(v[XI(1)], w); v[XI(2)] = cmul(v[XI(2)], w2); v[XI(3)] = cmul(v[XI(3)], w3); v[XI(4)] = cmul(v[XI(4)], w4);
  v[XI(5)] = cmul(v[XI(5)], w5); v[XI(6)] = cmul(v[XI(6)], w6); v[XI(7)] = cmul(v[XI(7)], w7); v[XI(8)] = cmul(v[XI(8)], w8);
  v[XI(9)] = cmul(v[XI(9)], cmul(w8, w)); v[XI(10)] = cmul(v[XI(10)], cmul(w8, w2)); v[XI(11)] = cmul(v[XI(11)], cmul(w8, w3)); v[XI(12)] = cmul(v[XI(12)], cmul(w8, w4));
  v[XI(13)] = cmul(v[XI(13)], cmul(w8, w5)); v[XI(14)] = cmul(v[XI(14)], cmul(w8, w6)); v[XI(15)] = cmul(v[XI(15)], cmul(w8, w7));
}
__device__ __forceinline__ void twiddle16n(f32x2 (&v)[16], f32x2 w) {
  asm volatile("" : "+v"(w.x), "+v"(w.y));
  const f32x2 w2 = cmul(w, w), w3 = cmul(w2, w), w4 = cmul(w2, w2), w5 = cmul(w4, w), w6 = cmul(w4, w2), w7 = cmul(w4, w3), w8 = cmul(w4, w4);
  v[1] = cmul(v[1], w); v[2] = cmul(v[2], w2); v[3] = cmul(v[3], w3); v[4] = cmul(v[4], w4); v[5] = cmul(v[5], w5); v[6] = cmul(v[6], w6); v[7] = cmul(v[7], w7); v[8] = cmul(v[8], w8);
  v[9] = cmul(v[9], cmul(w8, w)); v[10] = cmul(v[10], cmul(w8, w2)); v[11] = cmul(v[11], cmul(w8, w3)); v[12] = cmul(v[12], cmul(w8, w4));
  v[13] = cmul(v[13], cmul(w8, w5)); v[14] = cmul(v[14], cmul(w8, w6)); v[15] = cmul(v[15], cmul(w8, w7));
}
__device__ __forceinline__ int PADI(int i) { return i + (i >> 5); }
__device__ __forceinline__ float dpp_xor1(float x) { return __int_as_float(__builtin_amdgcn_mov_dpp(__float_as_int(x), 0xB1, 0xF, 0xF, true)); }

struct FftCtx { f32x2 w1; int P1, P2, P3, n3, t31;
  __device__ __forceinline__ f32x2 w2f() const { int q = t31; asm volatile("" : "+v"(q)); const float r = -(float)q * (1.0f / 512.0f); return (f32x2){__builtin_amdgcn_cosf(r), __builtin_amdgcn_sinf(r)}; }
  __device__ __forceinline__ f32x2 w3f() const { int q = n3; asm volatile("" : "+v"(q)); const float r = -(float)q * (1.0f / 32.0f); return (f32x2){__builtin_amdgcn_cosf(r), __builtin_amdgcn_sinf(r)}; } };

__device__ __forceinline__ void fft_fwd2(f32x2 (&x)[16], f32x2 (&y)[16], const FftCtx& c, f32x2* bufA, f32x2* bufB) {
  dft16<false>(x); twiddle16(x, c.w1); __builtin_amdgcn_sched_barrier(0); dft16<false>(y); twiddle16(y, c.w1); __builtin_amdgcn_sched_barrier(0);
#pragma unroll
  for (int k = 0; k < 16; ++k) { bufA[c.P1 + k * 528] = x[XI(k)]; bufB[c.P1 + k * 528] = y[XI(k)]; }
  __syncthreads();
#pragma unroll
  for (int n = 0; n < 16; ++n) { x[n] = bufA[c.P2 + n * 33]; y[n] = bufB[c.P2 + n * 33]; }
  dft16<false>(x); twiddle16(x, c.w2f()); __builtin_amdgcn_sched_barrier(0); dft16<false>(y); twiddle16(y, c.w2f()); __builtin_amdgcn_sched_barrier(0);
#pragma unroll
  for (int k = 0; k < 16; ++k) { bufA[c.P2 + k * 33] = x[XI(k)]; bufB[c.P2 + k * 33] = y[XI(k)]; }
  __syncthreads();
#pragma unroll
  for (int n = 0; n < 16; ++n) { x[n] = bufA[c.P3 + n * 2]; y[n] = bufB[c.P3 + n * 2]; }
  dft16<false>(x); twiddle16(x, c.w3f()); __builtin_amdgcn_sched_barrier(0); dft16<false>(y); twiddle16(y, c.w3f()); __builtin_amdgcn_sched_barrier(0);
#pragma unroll
  for (int i = 0; i < 16; ++i) { const f32x2 o = {dpp_xor1(x[i].x), dpp_xor1(x[i].y)}; x[i] = c.n3 ? (o - x[i]) : (x[i] + o);
                                 const f32x2 q = {dpp_xor1(y[i].x), dpp_xor1(y[i].y)}; y[i] = c.n3 ? (q - y[i]) : (y[i] + q); }
}
__device__ __forceinline__ void fft_inv2(f32x2 (&x)[16], f32x2 (&y)[16], const FftCtx& c, f32x2* bufA, f32x2* bufB) {
  f32x2 u[16], w[16];
#pragma unroll
  for (int k = 0; k < 16; ++k) { const f32x2 own = x[XI(k)]; const f32x2 o = {dpp_xor1(own.x), dpp_xor1(own.y)}; u[k] = c.n3 ? (o - own) : (own + o);
                                 const f32x2 owy = y[XI(k)]; const f32x2 q = {dpp_xor1(owy.x), dpp_xor1(owy.y)}; w[k] = c.n3 ? (q - owy) : (owy + q); }
  { const f32x2 q3 = c.w3f(); twiddle16n(u, (f32x2){q3.x, -q3.y}); } dft16<true>(u); __builtin_amdgcn_sched_barrier(0); { const f32x2 q3 = c.w3f(); twiddle16n(w, (f32x2){q3.x, -q3.y}); } dft16<true>(w); __builtin_amdgcn_sched_barrier(0);
#pragma unroll
  for (int n = 0; n < 16; ++n) { bufA[c.P3 + n * 2] = u[XI(n)]; bufB[c.P3 + n * 2] = w[XI(n)]; }
  __syncthreads();
#pragma unroll
  for (int k = 0; k < 16; ++k) { u[k] = bufA[c.P2 + k * 33]; w[k] = bufB[c.P2 + k * 33]; }
  { const f32x2 q2 = c.w2f(); twiddle16n(u, (f32x2){q2.x, -q2.y}); } dft16<true>(u); __builtin_amdgcn_sched_barrier(0); { const f32x2 q2 = c.w2f(); twiddle16n(w, (f32x2){q2.x, -q2.y}); } dft16<true>(w); __builtin_amdgcn_sched_barrier(0);
#pragma unroll
  for (int n = 0; n < 16; ++n) { bufA[c.P2 + n * 33] = u[XI(n)]; bufB[c.P2 + n * 33] = w[XI(n)]; }
  __syncthreads();
#pragma unroll
  for (int k = 0; k < 16; ++k) { u[k] = bufA[c.P1 + k * 528]; w[k] = bufB[c.P1 + k * 528]; }
  twiddle16n(u, (f32x2){c.w1.x, -c.w1.y}); dft16<true>(u); __builtin_amdgcn_sched_barrier(0); twiddle16n(w, (f32x2){c.w1.x, -c.w1.y}); dft16<true>(w); __builtin_amdgcn_sched_barrier(0);
#pragma unroll
  for (int i = 0; i < 16; ++i) { x[i] = u[i]; y[i] = w[i]; }
}

__device__ __forceinline__ float sconv(const bf16_t* col, int l, float w0, float w1, float w2, float cb) {
  const float um = bf2f(col[l - 1]), u0 = bf2f(col[l]), up = bf2f(col[l + 1]);
  return cb + w0 * (l > 0 ? um : 0.f) + w1 * u0 + w2 * (l < SEQ - 1 ? up : 0.f);
}

__device__ __forceinline__ void phase_hyena(KP p, int l, unsigned char* ldsraw) {
  f32x2* bufA = (f32x2*)ldsraw; f32x2* bufB = bufA + 8448;
  const int t = TIDX();
  FftCtx c; c.P1 = t + (t >> 5); c.P2 = (t >> 5) * 528 + (t & 31); c.P3 = (t >> 1) * 33 + (t & 1); c.n3 = t & 1; c.t31 = t & 31;
  { const float r1 = -(float)t * (1.0f / 8192.0f); c.w1 = (f32x2){__builtin_amdgcn_cosf(r1), __builtin_amdgcn_sinf(r1)}; }
  const float* TS = (const float*)(p->ws + A_MB16);
  const float* cw = inl(p, 8, l); const float* cbp = inl(p, 9, l); const float* dsk = inl(p, 18, l);
  const bf16_t* HT = (const bf16_t*)(p->ws + A_HTFT);
  bf16_t* Z2T = (bf16_t*)(p->ws + A_Z2T);
  f32x2* Hs = (f32x2*)(p->ws + A_HST + (size_t)BIDX() * 131072);
  for (int ch = BIDX(); ch < 1024; ch += GDIM()) {
    const float* tsa = TS + (size_t)ch * 8192; const float* tsb = TS + (size_t)(1024 + ch) * 8192;
    f32x2 x[16], y[16];
    { int tt = t; asm volatile("" : "+v"(tt));
#pragma unroll
      for (int i = 0; i < 16; ++i) { x[i] = (f32x2){tsa[i * 512 + tt], 0.f}; y[i] = (f32x2){tsb[i * 512 + tt], 0.f}; } }
    fft_fwd2(x, y, c, bufA, bufB);
    { int tt = t; asm volatile("" : "+v"(tt));
#pragma unroll
      for (int k = 0; k < 16; ++k) { Hs[k * 512 + tt] = x[XI(k)]; Hs[8192 + k * 512 + tt] = y[XI(k)]; } }
    float w0[3], w1[3], w2[3], cb[3];
#pragma unroll
    for (int q = 0; q < 3; ++q) { const int col = q * 1024 + ch; w0[q] = cw[col]; w1[q] = cw[3072 + col]; w2[q] = cw[6144 + col]; cb[q] = cbp[col]; }
    const float d1 = dsk[ch], d2 = dsk[1024 + ch];
    const bf16_t* colv = HT + (size_t)ch * NTOK; const bf16_t* colg = HT + (size_t)(1024 + ch) * NTOK; const bf16_t* colh = HT + (size_t)(2048 + ch) * NTOK;
    unsigned zp[8], zq[8];
    { int t1 = t; asm volatile("" : "+v"(t1));
#pragma unroll
      for (int n1 = 0; n1 < 8; ++n1) { const int pos = n1 * 512 + t1;
        zp[n1] = cvt_pk_bf16(sconv(colv, pos, w0[0], w1[0], w2[0], cb[0]), sconv(colv + SEQ, pos, w0[0], w1[0], w2[0], cb[0]));
        zq[n1] = cvt_pk_bf16(sconv(colv + 2 * SEQ, pos, w0[0], w1[0], w2[0], cb[0]), sconv(colv + 3 * SEQ, pos, w0[0], w1[0], w2[0], cb[0])); } }
#pragma unroll
    for (int o = 0; o < 2; ++o) {
      const float dd = o ? d2 : d1; const bf16_t* gc = o ? colh : colg; const int q = 1 + o;
#pragma unroll
      for (int i = 0; i < 8; ++i) { x[i] = (f32x2){bf2f(zp[i] & 0xffffu), bf2f(zp[i] >> 16)}; x[8 + i] = (f32x2){0.f, 0.f}; y[i] = (f32x2){bf2f(zq[i] & 0xffffu), bf2f(zq[i] >> 16)}; y[8 + i] = (f32x2){0.f, 0.f}; }
      fft_fwd2(x, y, c, bufA, bufB);
      { int tt = t; asm volatile("" : "+v"(tt));
#pragma unroll
        for (int k = 0; k < 16; ++k) { const f32x2 hh = Hs[o * 8192 + k * 512 + tt]; x[XI(k)] = cmul(x[XI(k)], hh); y[XI(k)] = cmul(y[XI(k)], hh); } }
      fft_inv2(x, y, c, bufA, bufB);
      { int t2 = t; asm volatile("" : "+v"(t2));
#pragma unroll
        for (int n1 = 0; n1 < 8; ++n1) { const int pos = n1 * 512 + t2; const f32x2 a = x[XI(n1)], b = y[XI(n1)];
          const float r0 = sconv(gc, pos, w0[q], w1[q], w2[q], cb[q]) * (a.x + dd * bf2f(zp[n1] & 0xffffu)), r1 = sconv(gc + SEQ, pos, w0[q], w1[q], w2[q], cb[q]) * (a.y + dd * bf2f(zp[n1] >> 16));
          const float r2 = sconv(gc + 2 * SEQ, pos, w0[q], w1[q], w2[q], cb[q]) * (b.x + dd * bf2f(zq[n1] & 0xffffu)), r3 = sconv(gc + 3 * SEQ, pos, w0[q], w1[q], w2[q], cb[q]) * (b.y + dd * bf2f(zq[n1] >> 16));
          zp[n1] = cvt_pk_bf16(r0, r1); zq[n1] = cvt_pk_bf16(r2, r3); } }
    }
    { bf16_t* o0 = Z2T + (size_t)ch * NTOK; int t3 = t; asm volatile("" : "+v"(t3));
#pragma unroll
      for (int n1 = 0; n1 < 8; ++n1) { o0[n1 * 512 + t3] = (bf16_t)(zp[n1] & 0xffffu); o0[SEQ + n1 * 512 + t3] = (bf16_t)(zp[n1] >> 16); o0[2 * SEQ + n1 * 512 + t3] = (bf16_t)(zq[n1] & 0xffffu); o0[3 * SEQ + n1 * 512 + t3] = (bf16_t)(zq[n1] >> 16); } }
  }
  __syncthreads();
}

__device__ __forceinline__ void phase_poolt(KP p, unsigned char* ldsraw) {
  const int tid = TIDX();
  bf16_t* tl = (bf16_t*)ldsraw;
  const bf16_t* Z2T = (const bf16_t*)(p->ws + A_Z2T); bf16_t* ZC = (bf16_t*)(p->ws + A_ZCAT); const bf16_t* PN = (const bf16_t*)(p->ws + A_PN);
  for (int tile = BIDX(); tile < 16 * 256; tile += GDIM()) {
    const int c0 = (tile & 15) * 64, t0 = (tile >> 4) * 64;
    const int i = tid >> 3, jj = (tid & 7) * 8;
    __syncthreads();
    { const u32x4 w = *(const u32x4*)(Z2T + (size_t)(c0 + i) * NTOK + t0 + jj);
      *(u32x4*)(tl + i * 72 + jj) = w; }
    __syncthreads();
    { unsigned e[8];
#pragma unroll
      for (int q = 0; q < 8; ++q) e[q] = tl[(jj + q) * 72 + i];
      u32x4 w; w.x = e[0] | (e[1] << 16); w.y = e[2] | (e[3] << 16); w.z = e[4] | (e[5] << 16); w.w = e[6] | (e[7] << 16);
      *(u32x4*)(ZC + (size_t)(t0 + i) * 2560 + c0 + jj) = w; }
  }
  for (size_t e = (size_t)BIDX() * 512 + tid; e < (size_t)NTOK * 64; e += (size_t)GDIM() * 512) {
    const int tok = (int)(e >> 6), c8 = (int)(e & 63) * 8, g = c8 >> 7, w = 2 << g, before = w >> 1, after = w - 1 - before;
    const int b = tok >> 12, l = tok & 4095;
    int lo = l - before; if (lo < 0) lo = 0; int hi = l + after; if (hi > SEQ - 1) hi = SEQ - 1;
    float s[8];
#pragma unroll
    for (int q = 0; q < 8; ++q) s[q] = 0.f;
    u32x4 wv[16];
#pragma unroll
    for (int j = 0; j < 16; ++j) { int r = l - before + j; r = r < 0 ? 0 : (r > SEQ - 1 ? SEQ - 1 : r); wv[j] = *(const u32x4*)(PN + (size_t)(b * SEQ + r) * 6656 + c8); }
#pragma unroll
    for (int j = 0; j < 16; ++j) { const int r = l - before + j; const float m = (j < w && r >= 0 && r <= SEQ - 1) ? 1.0f : 0.0f;
      s[0] += m * bf2f(wv[j].x & 0xffff); s[1] += m * bf2f(wv[j].x >> 16); s[2] += m * bf2f(wv[j].y & 0xffff); s[3] += m * bf2f(wv[j].y >> 16);
      s[4] += m * bf2f(wv[j].z & 0xffff); s[5] += m * bf2f(wv[j].z >> 16); s[6] += m * bf2f(wv[j].w & 0xffff); s[7] += m * bf2f(wv[j].w >> 16); }
    const u32x4 sv = *(const u32x4*)(PN + (size_t)tok * 6656 + c8);
    const float inv = 1.0f / (float)(hi - lo + 1);
    float o[8];
    o[0] = s[0] * inv - bf2f(sv.x & 0xffff); o[1] = s[1] * inv - bf2f(sv.x >> 16); o[2] = s[2] * inv - bf2f(sv.y & 0xffff); o[3] = s[3] * inv - bf2f(sv.y >> 16);
    o[4] = s[4] * inv - bf2f(sv.z & 0xffff); o[5] = s[5] * inv - bf2f(sv.z >> 16); o[6] = s[6] * inv - bf2f(sv.w & 0xffff); o[7] = s[7] * inv - bf2f(sv.w >> 16);
    u32x4 w4; w4.x = cvt_pk_bf16(o[0], o[1]); w4.y = cvt_pk_bf16(o[2], o[3]); w4.z = cvt_pk_bf16(o[4], o[5]); w4.w = cvt_pk_bf16(o[6], o[7]);
    *(u32x4*)(ZC + (size_t)tok * 2560 + 2048 + c8) = w4;
  }
  __syncthreads();
}

#define XB_TMO      128
#define XB_XCNT(j)  (256  + 64 * (j))
#define XB_XSUB(j)  (1280 + 64 * (j))
#define XB_XGEN(j)  (2304 + 64 * (j))
#define XB_TOP      3328
#define XB_TOPGEN   3392
#define XCD_BAR_WORDS 3456
#define XB_SPIN_CAP (1u << 18)

__device__ __forceinline__ unsigned xb_ld(unsigned* p)              { return __hip_atomic_load(p, __ATOMIC_RELAXED, __HIP_MEMORY_SCOPE_AGENT); }
__device__ __forceinline__ unsigned xb_add(unsigned* p, unsigned v) { return __hip_atomic_fetch_add(p, v, __ATOMIC_RELAXED, __HIP_MEMORY_SCOPE_AGENT); }
__device__ __forceinline__ unsigned xb_xcc_id() { return (unsigned)__builtin_amdgcn_s_getreg((3 << 11) | 20) & 0xFu; }
#define XB_SPIN(cond, bar) do { unsigned _sp = 0; while (cond) { __builtin_amdgcn_s_sleep(1); \
    if ((++_sp & 255u) == 0u) { if (xb_ld(&(bar)[XB_TMO])) break; if (_sp > XB_SPIN_CAP) { atomicAdd(&(bar)[XB_TMO], 1u); break; } } } } while (0)

struct XcdBarrier {
    unsigned* bar; unsigned x;
    volatile LAS unsigned* st;
};

__device__ __forceinline__ XcdBarrier xcd_barrier_post(unsigned* bar, volatile LAS unsigned* st) {
    XcdBarrier b; b.bar = bar; b.x = xb_xcc_id(); b.st = st;
    if (TIDX() == 0) (void)xb_add(&bar[XB_XCNT(b.x)], 1u);
    return b;
}
__device__ __forceinline__ void xcd_barrier_complete(unsigned* bar, unsigned x, unsigned& nloc, unsigned& nx) {
    const unsigned G = (unsigned)GDIM();
    unsigned sum, cnt, mine, sp = 0u;
    for (;;) {
        sum = 0u; cnt = 0u; mine = 0u;
#pragma unroll
        for (unsigned j = 0; j < 16; ++j) { const unsigned c = xb_ld(&bar[XB_XCNT(j)]); sum += c; cnt += (c > 0u) ? 1u : 0u; mine = (j == x) ? c : mine; }
        if (sum == G) break;
        __builtin_amdgcn_s_sleep(1);
        if ((++sp & 255u) == 0u) { if (xb_ld(&bar[XB_TMO])) break; if (sp > XB_SPIN_CAP) { atomicAdd(&bar[XB_TMO], 1u); break; } }
    }
    nloc = mine > 0u ? mine : 1u; nx = cnt > 0u ? cnt : 1u;
}

__device__ __forceinline__ void xcd_barrier(const XcdBarrier& b) {
    asm volatile("s_waitcnt vmcnt(0)" ::: "memory");
    __syncthreads();
    if (TIDX() == 0) {
        unsigned* bar = b.bar; asm volatile("" : "+s"(bar));
        __builtin_amdgcn_s_waitcnt(0);
        unsigned nloc = b.st[0], nx = b.st[1];
        if (nloc == 0u) { xcd_barrier_complete(bar, b.x, nloc, nx); b.st[0] = nloc; b.st[1] = nx; }
        const unsigned old = xb_add(&bar[XB_XSUB(b.x)], 1u);
        const unsigned gen = old / nloc;
        if (old + 1u == (gen + 1u) * nloc) {
            __builtin_amdgcn_fence(__ATOMIC_RELEASE, "agent");
            asm volatile("s_waitcnt vmcnt(0)" ::: "memory");
            const unsigned og = xb_add(&bar[XB_TOP], 1u);
            const unsigned tg = og / nx;
            if (og + 1u == (tg + 1u) * nx) xb_add(&bar[XB_TOPGEN], 1u);
            else XB_SPIN(xb_ld(&bar[XB_TOPGEN]) == tg, bar);
            __builtin_amdgcn_fence(__ATOMIC_ACQUIRE, "agent");
            xb_add(&bar[XB_XGEN(b.x)], 1u);
            asm volatile("s_waitcnt vmcnt(0)" ::: "memory");
        } else {
            XB_SPIN(xb_ld(&bar[XB_XGEN(b.x)]) == gen, bar);
            __builtin_amdgcn_fence(__ATOMIC_ACQUIRE, "agent");
            asm volatile("s_waitcnt vmcnt(0)" ::: "memory");
        }
    }
    __syncthreads();
}


__device__ __forceinline__ void run_phase(KP p, int ph, unsigned char* lds) {
  LAS unsigned char* ldsl = (LAS unsigned char*)lds;
  float* ldsf = (float*)lds;
  pg8::Sched S;
  if (ph == 0) {
    phase_conv(p, 0, ldsf);
    phase_dftm(p, ldsf);
    phase_prep(p);
    phase_hid(p, 0);
    return;
  }
  const int l = (ph - 1) / 17, k = (ph - 1) % 17;
#define WSDEF unsigned char* ws = p->ws; asm volatile("" : "+s"(ws)); bf16_t* wb = (bf16_t*)ws;
  switch (k) {
    case 0: case 14: { WSDEF
      if (l == 1) {
        pg8::EpiSwiGLU E{(bf16_t*)(ws + A_H), nullptr, 1.0f / (F8_SA * F8_SW), k == 14 ? 1 : 0};
        S.init(0, ws + O_XB8, wb + (k == 0 ? O_WGU1 : O_WGU2) / 2, DM / 2, DM / 2, NTOK, 2 * DFF, 0); pg8::gemm_phase<pg8::EpiSwiGLU, true>(ldsl, S, DM / 128, E);
      } else {
        pg8::EpiSwiGLU E{(bf16_t*)(ws + A_H), (const float*)(ws + O_RSTD), 1.0f, 0};
        S.init(0, ws + O_XB, wb + (k == 0 ? O_WGU1 : O_WGU2) / 2, DM, DM, NTOK, 2 * DFF, 0); pg8::gemm_phase(ldsl, S, DM / 64, E);
      } } break;
    case 1: case 15: { WSDEF
      if (k == 15 && l == 1) {
        pg8::EpiY E{(bf16_t*)(ws + A_Y), (float*)(ws + O_PART), 1.0f / (F8_SH * F8_SW)};
        S.init(0, ws + A_H, wb + O_WD2 / 2, DFF / 2, DFF / 2, NTOK, DM, 0); pg8::gemm_phase<pg8::EpiY, true>(ldsl, S, DFF / 128, E);
      } else {
        pg8::EpiY E{(bf16_t*)(ws + A_Y), (float*)(ws + O_PART), 1.0f};
        S.init(0, ws + A_H, wb + (k == 1 ? O_WD1 : O_WD2) / 2, DFF, DFF, NTOK, DM, 0); pg8::gemm_phase(ldsl, S, DFF / 64, E);
      } } break;
    case 2: phase_resid(p, (l == 0) ? p->in[0] : p->out, inl(p, 5, l), 0.5f, false); break;
    case 3: { WSDEF
      { pg8::EpiColBf16 E{(bf16_t*)(ws + A_HTFT), (const float*)(ws + O_RSTD), 1}; S.init(0, wb + O_WINT / 2, ws + O_XB, DM, DM, 4096, NTOK, 0); pg8::gemm_phase(ldsl, S, DM / 64, E); }
      { pg8::EpiRowBf16 E{(bf16_t*)(ws + A_PN), 6656, (const float*)(ws + O_RSTD), 1, 512}; S.init(0, ws + O_XB, wb + O_WINN / 2, DM, DM, NTOK, 6656, 0); pg8::gemm_phase(ldsl, S, DM / 64, E); }
      { pg8::EpiRowBf16 E{(bf16_t*)(ws + O_KB), DM, (const float*)(ws + O_RSTDM), 0, 0}; S.init(0, ws + O_MB, wb + O_WK / 2, DM, DM, MEMROWS, DM, 0); S.c = (S.c + 128) & 255; pg8::gemm_phase(ldsl, S, DM / 64, E); }
      { pg8::EpiColBf16 E{(bf16_t*)(ws + O_VT), (const float*)(ws + O_RSTDM), 0}; S.init(0, wb + O_WV / 2, ws + O_MB, DM, DM, DM, MEMROWS, 0); S.c = (S.c + 96) & 255; pg8::gemm_phase(ldsl, S, DM / 64, E); }
      { pg8::EpiFilt E{(float*)(ws + A_MB16)}; S.init(0, ws + O_W4T, ws + O_HIDB, 256, 256, 4096, 4096, 0); pg8::gemm_phase(ldsl, S, 256 / 64, E); }
    } break;
    case 4: { WSDEF
#ifndef NO_HYENA
      phase_hyena(p, l, lds);
#endif
      pg8::EpiRowBf16 E{(bf16_t*)(ws + A_ZCAT), 2560, nullptr, 0, 0}; S.init(3, ws + O_DFTM, ws + A_HTFT + (size_t)3072 * NTOK * 2, 8192, 8192, 256 * 16, 256 * 16, 0); pg8::gemm_phase(ldsl, S, 4096 / 64, E);
    } break;
    case 5: phase_poolt(p, lds); break;
    case 6: { WSDEF
      float* MF = (float*)(ws + A_MF); bf16_t* MB16 = (bf16_t*)(ws + A_MB16); const bf16_t* PN = (const bf16_t*)(ws + A_PN);
      { pg8::EpiMerge<0> E{MF, MB16, PN}; S.init(0, ws + A_ZCAT, wb + O_WM / 2, 2560, 2560, NTOK, DM, 0); pg8::gemm_phase(ldsl, S, 1024 / 64, E); }
      { pg8::EpiMerge<1> E{MF, MB16, PN}; S.init(0, ws + A_ZCAT, wb + O_WM / 2, 2560, 2560, NTOK, DM, 1024); pg8::gemm_phase(ldsl, S, 1024 / 64, E); }
      { pg8::EpiMerge<2> E{MF, MB16, PN}; S.init(0, ws + A_ZCAT, wb + O_WM / 2, 2560, 2560, NTOK, DM, 2048); pg8::gemm_phase(ldsl, S, 512 / 64, E); }
    } break;
    case 7: case 12: { WSDEF
      pg8::EpiY E{(bf16_t*)(ws + A_Y), (float*)(ws + O_PART), 1.0f};
      S.init(0, ws + (k == 7 ? A_MB16 : A_O), wb + (k == 7 ? O_WOUT : O_WO) / 2, DM, DM, NTOK, DM, 0); pg8::gemm_phase(ldsl, S, DM / 64, E); } break;
    case 8: phase_resid(p, p->out, inl(p, 24, l), 1.0f, false); break;
    case 9: { WSDEF pg8::EpiRowBf16 E{(bf16_t*)(ws + A_Q), DM, (const float*)(ws + O_RSTD), 0, 0}; S.init(0, ws + O_XB, wb + O_WQ / 2, DM, DM, NTOK, DM, 0); pg8::gemm_phase(ldsl, S, DM / 64, E); } break;
    case 10: { WSDEF pg8::EpiSoftmax E{(bf16_t*)(ws + A_P), 0.044194173824159216f * 1.4426950408889634f}; S.init(1, ws + A_Q, ws + O_KB, DM, DM, 256 * 16, 256 * 16, 0); pg8::gemm_phase(ldsl, S, 512 / 64, E); } break;
    case 11: { WSDEF pg8::EpiRowBf16 E{(bf16_t*)(ws + A_O), DM, nullptr, 0, 0}; S.init(2, ws + A_P, ws + O_VT, 1024, 1024, 256 * 32, 256 * 16, 0); pg8::gemm_phase(ldsl, S, 256 / 64, E); } break;
    case 13: phase_resid(p, p->out, inl(p, 30, l), 1.0f, l == 1); break;
    case 16: phase_resid(p, p->out, inl(p, 34, l), 0.5f, l == 0);
#ifndef NO_CONV
      if (l == 0) { phase_conv(p, 1, ldsf); phase_hid(p, 1); }
#endif
      break;
    default: break;
  }
}

__global__ void __launch_bounds__(512, 2) mk_fwd(Params p) {
  unsigned char* lds = g_lds;
  cg::grid_group grid = cg::this_grid();
  volatile LAS unsigned* st = (volatile LAS unsigned*)((LAS unsigned char*)lds + (LDS_BYTES - 16));
  { const int tid0 = (int)threadIdx.x;
    const unsigned hw = (unsigned)__builtin_amdgcn_s_getreg(((6 - 1) << 11) | 4) & 63u;
    if ((tid0 & 63) == 0) *(volatile LAS int*)((LAS unsigned char*)lds + WTAB_OFF + hw * 4) = tid0 >> 6;
    if (tid0 == 0) { st[0] = 0u; st[1] = 0u; } }
  __syncthreads();
  const XcdBarrier xb = xcd_barrier_post((unsigned*)(p.ws + O_BAR), st);
#ifndef REP_K
#define REP_K -1
#endif
  { KP kp = (KP)__builtin_amdgcn_kernarg_segment_ptr(); asm volatile("" : "+s"(kp));
    run_phase(kp, 0, lds); }
  grid.sync();
  for (int ph = 1; ph < 35; ++ph) {
    int nrep = 1;
    if (REP_K >= 0 && REP_K < 17 && (ph - 1) % 17 == REP_K && (REP_K != 2 || ph < 18)) nrep = 2;
    for (int r = 0; r < nrep; ++r) {
      KP kp = (KP)__builtin_amdgcn_kernarg_segment_ptr(); asm volatile("" : "+s"(kp));
      run_phase(kp, ph, lds);
      if (ph != 34 || r != nrep - 1) xcd_barrier(xb);
    }
  }
}

extern "C" void kernel_launch(void* const* d_in, const int* in_sizes, int n_in, void* d_out, int out_size,
                              void* d_ws, size_t ws_size, hipStream_t stream) {
  static int grid_blocks = 0;
  if (!grid_blocks) {
    int dev = 0, cus = 0, per_cu = 0;
    (void)hipGetDevice(&dev);
    (void)hipDeviceGetAttribute(&cus, hipDeviceAttributeMultiprocessorCount, dev);
    (void)hipFuncSetAttribute((const void*)mk_fwd, hipFuncAttributeMaxDynamicSharedMemorySize, LDS_BYTES);
    (void)hipOccupancyMaxActiveBlocksPerMultiprocessor(&per_cu, (const void*)mk_fwd, 512, LDS_BYTES);
    if (per_cu < 1) per_cu = 1;
    grid_blocks = cus * per_cu;
    if (grid_blocks != 256 || ws_size < A_END || n_in != NIN)
      fprintf(stderr, "kernel_launch: unexpected configuration: grid %d (cus %d x %d), ws %zu (need %zu), n_in %d\n", grid_blocks, cus, per_cu, ws_size, (size_t)A_END, n_in);
  }
  (void)hipMemsetAsync((char*)d_ws + O_BAR, 0, 16384, stream);
  Params p{};
  for (int i = 0; i < NIN; ++i) { p.in[i] = (const float*)d_in[i]; p.lsz[i] = in_sizes[i] / 2; }
  p.out = (float*)d_out; p.ws = (unsigned char*)d_ws; p.pad = 0;
  void* args[] = {&p};
  hipError_t e = hipLaunchCooperativeKernel((void*)mk_fwd, dim3(grid_blocks), dim3(512), args, LDS_BYTES, stream);
  if (e != hipSuccess) fprintf(stderr, "cooperative launch failed: %s (grid %d)\n", hipGetErrorString(e), grid_blocks);
}
```

```cpp
#include <hip/hip_runtime.h>
#include <hip/hip_cooperative_groups.h>
#include <cstdio>
namespace cg = cooperative_groups;

#define LAS __attribute__((address_space(3)))
typedef unsigned short bf16_t;
typedef short bf16x8 __attribute__((ext_vector_type(8)));
typedef float f32x4 __attribute__((ext_vector_type(4)));
typedef float f32x2 __attribute__((ext_vector_type(2)));
typedef unsigned u32x4 __attribute__((ext_vector_type(4)));
typedef unsigned u32x2 __attribute__((ext_vector_type(2)));

constexpr int NTOK = 16384, DM = 2048, DFF = 5632, SEQ = 4096, NB = 4, MEMROWS = 1024;
constexpr int NIN = 35;
constexpr float RMS_EPS = 1e-6f;
constexpr float F8_SA = 16.0f, F8_SW = 512.0f, F8_SH = 8.0f;
constexpr int LDS_BYTES = 137216;

constexpr size_t E_WGU = 23068672, E_WD = 11534336, E_WINT = 8388608, E_WINN = 13631488, E_WM = 5242880, E_SQ = 4194304;
constexpr size_t O_WGU1 = 0, O_WD1 = O_WGU1 + 2 * E_WGU, O_WINT = O_WD1 + 2 * E_WD, O_WINN = O_WINT + 2 * E_WINT, O_WM = O_WINN + 2 * E_WINN,
                 O_WOUT = O_WM + 2 * E_WM, O_WQ = O_WOUT + 2 * E_SQ, O_WK = O_WQ + 2 * E_SQ, O_WV = O_WK + 2 * E_SQ, O_WO = O_WV + 2 * E_SQ,
                 O_WGU2 = O_WO + 2 * E_SQ, O_WD2 = O_WGU2 + 2 * E_WGU, O_WEND = O_WD2 + 2 * E_WD;
constexpr size_t O_XB = O_WEND, O_DFTM = O_XB + (size_t)NTOK * DM * 2, O_MB = O_DFTM + (size_t)4096 * 8192 * 2, O_KB = O_MB + (size_t)MEMROWS * DM * 2,
                 O_VT = O_KB + (size_t)MEMROWS * DM * 2, O_HID = O_VT + (size_t)MEMROWS * DM * 2, O_PART = O_HID + (size_t)4096 * 64 * 4,
                 O_RSTD = O_PART + (size_t)NTOK * 32 * 4, O_RSTDM = O_RSTD + (size_t)NTOK * 4, O_BAR = O_RSTDM + 4096, O_ARENA = O_BAR + 16384;
constexpr size_t A_HTFT = O_ARENA, A_PN = A_HTFT + (size_t)4096 * NTOK * 2, A_ZCAT = A_PN + (size_t)NTOK * 6656 * 2, A_MB16 = A_ZCAT + (size_t)NTOK * 2560 * 2,
                 A_HST = A_MB16 + (size_t)NTOK * DM * 2, A_Z2T = A_HST + (size_t)256 * 131072, O_XB8 = A_Z2T + (size_t)1024 * NTOK * 2, O_W4T = O_XB8 + (size_t)NTOK * DM, O_HIDB = O_W4T + (size_t)4096 * 256 * 2, A_END = O_HIDB + (size_t)4096 * 256 * 2;
constexpr size_t A_H = O_ARENA, A_Y = A_PN + (size_t)NTOK * 2560 * 2  , A_MF = A_HTFT, A_Q = O_ARENA, A_P = A_Q + (size_t)NTOK * DM * 2,
                 A_O = A_P + (size_t)NTOK * 1024 * 2;
static_assert(A_Y + (size_t)NTOK * DM * 4 <= A_ZCAT, "y must fit in PN tail");
static_assert(A_O + (size_t)NTOK * DM * 2 <= A_Y, "attention buffers below y");
static_assert(A_H + (size_t)NTOK * DFF * 2 <= A_Y, "H below y");

struct Params {
  const float* in[NIN];
  float* out;
  unsigned char* ws;
  int lsz[NIN];
  int pad;
};

typedef const __attribute__((address_space(4))) Params* KP;
constexpr int WTAB_OFF = LDS_BYTES - 16 - 256;
extern __shared__ __attribute__((aligned(16))) unsigned char g_lds[];
__device__ __forceinline__ int TIDX() {
  int lane; asm volatile("v_mbcnt_lo_u32_b32 %0, -1, 0\n\tv_mbcnt_hi_u32_b32 %0, -1, %0" : "=v"(lane));
  const unsigned hw = (unsigned)__builtin_amdgcn_s_getreg(((6 - 1) << 11) | 4) & 63u;
  const int wave = *(volatile LAS int*)((LAS unsigned char*)g_lds + WTAB_OFF + hw * 4);
  return wave * 64 + lane;
}
__device__ __forceinline__ int BIDX() { int b = __builtin_amdgcn_workgroup_id_x(); asm volatile("" : "+s"(b)); return b; }
__device__ __forceinline__ int GDIM() { int g = (int)__ockl_get_num_groups(0); asm volatile("" : "+s"(g)); return g; }
__device__ __forceinline__ unsigned cvt_pk_bf16(float lo, float hi) { unsigned r; asm("v_cvt_pk_bf16_f32 %0, %1, %2" : "=v"(r) : "v"(lo), "v"(hi)); return r; }
__device__ __forceinline__ unsigned cvt4_fp8(float a, float b, float c, float d) { int w = 0; w = __builtin_amdgcn_cvt_pk_fp8_f32(a, b, w, false); w = __builtin_amdgcn_cvt_pk_fp8_f32(c, d, w, true); return (unsigned)w; }
__device__ __forceinline__ float bf2f(unsigned b) { return __uint_as_float(b << 16); }
__device__ __forceinline__ bf16_t f2bf(float f) { return (bf16_t)(cvt_pk_bf16(f, 0.f) & 0xffffu); }
__device__ __forceinline__ float shfl_xor_f(float v, int m) { const int lane = TIDX() & 63; return __int_as_float(__builtin_amdgcn_ds_bpermute((lane ^ m) << 2, __float_as_int(v))); }
__device__ __forceinline__ float wave_sum(float v) {
  v += __int_as_float(__builtin_amdgcn_ds_swizzle(__float_as_int(v), (16 << 10) | 0x1F));
  v += __int_as_float(__builtin_amdgcn_ds_swizzle(__float_as_int(v), (8 << 10) | 0x1F));
  v += __int_as_float(__builtin_amdgcn_ds_swizzle(__float_as_int(v), (4 << 10) | 0x1F));
  v += __int_as_float(__builtin_amdgcn_ds_swizzle(__float_as_int(v), (2 << 10) | 0x1F));
  v += __int_as_float(__builtin_amdgcn_ds_swizzle(__float_as_int(v), (1 << 10) | 0x1F));
  return __int_as_float(__builtin_amdgcn_readlane(__float_as_int(v), 0)) + __int_as_float(__builtin_amdgcn_readlane(__float_as_int(v), 32));
}

namespace pg8 {
constexpr int BM = 256, BK = 64, HALF = 128, HTB = HALF * BK * 2, STAGE_BYTES = 8 * HTB, NXCD = 8, WGM = 8;
__device__ __forceinline__ int lds_byte(int r, int c) { const int st = (r >> 4) * 2 + (c >> 5), rr = r & 15, cc = c & 31, ob = rr * 64 + cc * 2; return st * 1024 + (ob ^ (((ob >> 9) & 1) << 5)); }
__device__ __forceinline__ void stage_rc(int b, int& R, int& C) { const int st = b / 1024, sb = b % 1024, swz = sb ^ (((sb >> 9) & 1) << 5); R = (st >> 1) * 16 + swz / 64; C = (st & 1) * 32 + (swz % 64) / 2; }
__device__ __forceinline__ int perm32(int rho) { const int n = rho >> 4, i = rho & 15; return 8 * (i >> 2) + 4 * n + (i & 3); }

struct Unit { const char* a; const char* b; int pm, pn; };

struct Sched {
  int mode; const char* A; const char* B; int lda, ldb, nM, nN, nwg, G, c, koff;
  __device__ __forceinline__ void init(int mode_, const void* A_, const void* B_, int lda_, int ldb_, int M, int N, int koff_) {
    mode = mode_; A = (const char*)A_; B = (const char*)B_; lda = lda_; ldb = ldb_; nM = M / BM; nN = N / BM; nwg = nM * nN; G = (int)GDIM(); c = (int)BIDX(); koff = koff_;
  }
  __device__ __forceinline__ bool next(int i, Unit& u) const {
    const long Lq = (long)i * G + c; if (Lq >= nwg) return false;
    int wgid = (int)Lq;
    if (mode == 0) {
      { const int q = nwg / NXCD, r = nwg % NXCD, xcd = wgid % NXCD, off = wgid / NXCD; wgid = (xcd < r ? xcd * (q + 1) : r * (q + 1) + (xcd - r) * q) + off; }
      const int nig = WGM * nN, gid = wgid / nig, fm = gid * WGM, gsz = (nM - fm) < WGM ? (nM - fm) : WGM;
      u.pm = fm + ((wgid % nig) % gsz); u.pn = (wgid % nig) / gsz;
      u.a = A + ((size_t)u.pm * BM * lda + koff) * 2; u.b = B + ((size_t)u.pn * BM * ldb + koff) * 2;
    } else if (mode == 1) {
      const int b = wgid >> 6, h = (wgid >> 4) & 3, qt = wgid & 15;
      u.pm = b * 16 + qt; u.pn = h;
      u.a = A + ((size_t)(b * 4096 + qt * 256) * 2048 + h * 512) * 2; u.b = B + ((size_t)(b * 256) * 2048 + h * 512) * 2;
    } else if (mode == 2) {
      const int dt = wgid & 1, qt = (wgid >> 1) & 15, h = (wgid >> 5) & 3, b = wgid >> 7;
      u.pm = b * 16 + qt; u.pn = h * 2 + dt;
      u.a = A + ((size_t)(b * 4096 + qt * 256) * 1024 + h * 256) * 2; u.b = B + ((size_t)(h * 512 + dt * 256) * 1024 + b * 256) * 2;
    } else {
      const int x = wgid & 7, j = wgid >> 3, b = x >> 1, s = x & 1, kt = j >> 1, mt = j & 1;
      u.pm = b * 16 + kt; u.pn = 4 + s * 2 + mt;
      u.a = A + ((size_t)(kt * 256) * 8192 + s * 4096) * 2; u.b = B + ((size_t)(b * 512 + mt * 256) * 8192 + s * 4096) * 2;
    }
    return true;
  }
};

typedef int i32x4v __attribute__((ext_vector_type(4)));
typedef int i32x8v __attribute__((ext_vector_type(8)));
template <class Epi, bool F8 = false>
__device__ __forceinline__ void gemm_phase(LAS unsigned char* lds, const Sched& S, int nt, const Epi& E) {
    int tid = TIDX(); asm volatile("" : "+v"(tid));
    const int wid = __builtin_amdgcn_readfirstlane(tid >> 6), lane = tid & 63, wr = wid >> 2, wc = wid & 3, fr = lane & 15, fq = lane >> 4;
    unsigned voffA[1], voffB[1];
    { int R, C; stage_rc(tid * 16, R, C); const int Rb = Epi::PERM ? ((R & ~31) + perm32(R & 31)) : R;
        voffA[0] = (unsigned)(R * S.lda + C) * 2u; voffB[0] = (unsigned)(Rb * S.ldb + C) * 2u; }
    const size_t qstepA = (size_t)64 * S.lda * 2, qstepB = (size_t)64 * S.ldb * 2;
    const size_t kstep = (size_t)(BK * 2);
    const size_t hstepA = (size_t)HALF * S.lda * 2, hstepB = (size_t)HALF * S.ldb * 2;
    const unsigned ldsw = (unsigned)wid * 1024u;
    const int aoff = lds_byte(wr * 64 + fr, fq * 8), boff = lds_byte(wc * 32 + fr, fq * 8);
#define PG8_SA(b, h) (((b) * 2 + (h)) * HTB)
#define PG8_SB(b, h) ((4 + (b) * 2 + (h)) * HTB)
#define PG8_STAGE(bufoff, gbase, voff) do { _Pragma("unroll") for (int _i = 0; _i < 2; ++_i) \
        __builtin_amdgcn_global_load_lds((const unsigned*)((const char*)(gbase) + (size_t)_i * q##voff + (voff)[0]), (LAS unsigned*)(lds + (bufoff) + ldsw + _i * 8192), 16, 0, 0); } while (0)
#define qvoffA qstepA
#define qvoffB qstepB
#define PG8_LDA(dst, b, h) do { if constexpr (F8) { _Pragma("unroll") for (int m = 0; m < 4; ++m) dst##8[m] = __builtin_shufflevector(*(const LAS i32x4v*)(lds + PG8_SA(b, h) + aoff + m * 2048), *(const LAS i32x4v*)(lds + PG8_SA(b, h) + aoff + m * 2048 + 1024), 0, 1, 2, 3, 4, 5, 6, 7); } \
        else { _Pragma("unroll") for (int m = 0; m < 4; ++m) _Pragma("unroll") for (int k = 0; k < 2; ++k) dst[m][k] = *(const LAS bf16x8*)(lds + PG8_SA(b, h) + aoff + m * 2048 + k * 1024); } } while (0)
#define PG8_LDB(dst, b, h) do { if constexpr (F8) { _Pragma("unroll") for (int n = 0; n < 2; ++n) dst##8[n] = __builtin_shufflevector(*(const LAS i32x4v*)(lds + PG8_SB(b, h) + boff + n * 2048), *(const LAS i32x4v*)(lds + PG8_SB(b, h) + boff + n * 2048 + 1024), 0, 1, 2, 3, 4, 5, 6, 7); } \
        else { _Pragma("unroll") for (int n = 0; n < 2; ++n) _Pragma("unroll") for (int k = 0; k < 2; ++k) dst[n][k] = *(const LAS bf16x8*)(lds + PG8_SB(b, h) + boff + n * 2048 + k * 1024); } } while (0)
#define PG8_MMA(ai, bj, At, Bt) do { __builtin_amdgcn_s_setprio(1); \
        if constexpr (F8) { _Pragma("unroll") for (int m = 0; m < 4; ++m) _Pragma("unroll") for (int n = 0; n < 2; ++n) \
            asm volatile("v_mfma_scale_f32_16x16x128_f8f6f4 %0, %1, %2, %0, %3, %3 op_sel_hi:[0,0,0]" : "+v"(acc[ai][bj][m][n]) : "v"(Bt##8[n]), "v"(At##8[m]), "v"(f8scale)); } \
        else { _Pragma("unroll") for (int m = 0; m < 4; ++m) _Pragma("unroll") for (int n = 0; n < 2; ++n) _Pragma("unroll") for (int k = 0; k < 2; ++k) \
            acc[ai][bj][m][n] = __builtin_amdgcn_mfma_f32_16x16x32_bf16(Bt[n][k], At[m][k], acc[ai][bj][m][n], 0, 0, 0); } \
        __builtin_amdgcn_s_setprio(0); } while (0)
#define PG8_WAIT_V(n) asm volatile("s_waitcnt vmcnt(" #n ")" ::: "memory")
#define PG8_WAIT_L(n) asm volatile("s_waitcnt lgkmcnt(" #n ")" ::: "memory")
#define PG8_BAR __builtin_amdgcn_s_barrier()
#define PG8_SCHED __builtin_amdgcn_sched_barrier(0)
    Unit cur, nxt; int ui = 0;
    if (!S.next(0, cur)) return;
    f32x4 acc[2][2][4][2];
#pragma unroll
    for (int a = 0; a < 2; ++a)
#pragma unroll
        for (int b = 0; b < 2; ++b)
#pragma unroll
            for (int m = 0; m < 4; ++m)
#pragma unroll
                for (int n = 0; n < 2; ++n) acc[a][b][m][n] = (f32x4){0.f, 0.f, 0.f, 0.f};
    bf16x8 At[4][2], B0[2][2], B1[2][2]; i32x8v At8[4], B08[2], B18[2]; const int f8scale = 0x7f7f7f7f;
    const char* cA = cur.a; const char* cB = cur.b;
    PG8_STAGE(PG8_SB(0, 0), cB, voffB); PG8_STAGE(PG8_SA(0, 0), cA, voffA); PG8_STAGE(PG8_SB(0, 1), cB + hstepB, voffB); PG8_STAGE(PG8_SA(0, 1), cA + hstepA, voffA);
    if (wr == 1) PG8_BAR;
    PG8_WAIT_V(4); PG8_BAR;
    PG8_STAGE(PG8_SB(1, 0), cB + kstep, voffB); PG8_STAGE(PG8_SA(1, 0), cA + kstep, voffA); PG8_STAGE(PG8_SB(1, 1), cB + hstepB + kstep, voffB);
    PG8_WAIT_V(6); PG8_BAR;
    for (;;) {
        const bool has_next = S.next(ui + 1, nxt);
        const char* nA = has_next ? nxt.a : cA; const char* nB = has_next ? nxt.b : cB;
        for (int t = 0; t < nt; t += 2) {
            const bool last = (t == nt - 2);
            const char* a1 = cA + (size_t)(t + 1) * kstep;
            const char* a2 = last ? nA : cA + (size_t)(t + 2) * kstep; const char* b2 = last ? nB : cB + (size_t)(t + 2) * kstep;
            const char* a3 = a2 + kstep; const char* b3 = b2 + kstep;
            PG8_LDB(B0, 0, 0); PG8_SCHED; PG8_LDA(At, 0, 0); PG8_STAGE(PG8_SA(1, 1), a1 + hstepA, voffA);
            PG8_WAIT_L(8); PG8_BAR; PG8_WAIT_L(0); PG8_MMA(0, 0, At, B0); PG8_BAR; PG8_SCHED;
            PG8_LDB(B1, 0, 1); PG8_STAGE(PG8_SB(0, 0), b2, voffB);
            PG8_BAR; PG8_WAIT_L(0); PG8_MMA(0, 1, At, B1); PG8_BAR;
            PG8_LDA(At, 0, 1); PG8_STAGE(PG8_SA(0, 0), a2, voffA);
            PG8_BAR; PG8_WAIT_L(0); PG8_MMA(1, 0, At, B0); PG8_BAR; PG8_SCHED;
            PG8_STAGE(PG8_SB(0, 1), b2 + hstepB, voffB);
            PG8_WAIT_V(6); PG8_BAR; PG8_MMA(1, 1, At, B1); PG8_BAR;
            PG8_LDB(B0, 1, 0); PG8_SCHED; PG8_LDA(At, 1, 0); PG8_STAGE(PG8_SA(0, 1), a2 + hstepA, voffA);
            PG8_WAIT_L(8); PG8_BAR; PG8_WAIT_L(0); PG8_MMA(0, 0, At, B0); PG8_BAR; PG8_SCHED;
            PG8_LDB(B1, 1, 1); PG8_STAGE(PG8_SB(1, 0), b3, voffB);
            PG8_BAR; PG8_WAIT_L(0); PG8_MMA(0, 1, At, B1); PG8_BAR;
            PG8_LDA(At, 1, 1); PG8_STAGE(PG8_SA(1, 0), a3, voffA);
            PG8_BAR; PG8_WAIT_L(0); PG8_MMA(1, 0, At, B0); PG8_BAR; PG8_SCHED;
            PG8_STAGE(PG8_SB(1, 1), b3 + hstepB, voffB);
            PG8_WAIT_V(6); PG8_BAR; PG8_MMA(1, 1, At, B1); PG8_BAR;
        }
        if constexpr (F8) { asm volatile("s_nop 15\n\ts_nop 15\n\ts_nop 15\n\ts_nop 15" ::: "memory"); }
        if constexpr (!Epi::AFTER_DRAIN) { E(acc, cur, wr, wc, fr, fq); }
        if (!has_next) break;
#pragma unroll
        for (int a = 0; a < 2; ++a)
#pragma unroll
            for (int b = 0; b < 2; ++b)
#pragma unroll
                for (int m = 0; m < 4; ++m)
#pragma unroll
                    for (int n = 0; n < 2; ++n) acc[a][b][m][n] = (f32x4){0.f, 0.f, 0.f, 0.f};
        cur = nxt; cA = nA; cB = nB; ++ui;
    }
    PG8_WAIT_V(0);
    if (wr == 0) PG8_BAR;
    PG8_BAR;
    if constexpr (Epi::AFTER_DRAIN) { E.fused(acc, cur, wr, wc, fr, fq, lds, wid, lane); }
#undef PG8_SA
#undef PG8_SB
#undef PG8_STAGE
#undef qvoffA
#undef qvoffB
#undef PG8_LDA
#undef PG8_LDB
#undef PG8_MMA
#undef PG8_WAIT_V
#undef PG8_WAIT_L
#undef PG8_BAR
#undef PG8_SCHED
}

typedef f32x4 Acc[2][2][4][2];

struct EpiSwiGLU {
  static constexpr bool PERM = true, AFTER_DRAIN = false;
  bf16_t* H; const float* rs; float cscale; int h8;
  __device__ __forceinline__ void operator()(const Acc& acc, const Unit& u, int wr_, int wc_, int fr_, int fq_) const {
    const int tid_ = TIDX(), lane_ = tid_ & 63, wid_ = tid_ >> 6, wr = wid_ >> 2, wc = wid_ & 3, fr = lane_ & 15, fq = lane_ >> 4;
    const int row0 = u.pm * BM + wr * 64 + fr, col0 = u.pn * 128 + wc * 32 + 8 * fq;
#pragma unroll
    for (int ai = 0; ai < 2; ++ai)
#pragma unroll
      for (int m = 0; m < 4; ++m) {
        const int row = row0 + ai * HALF + m * 16; const float r = rs ? rs[row] : cscale;
        float o[8];
#pragma unroll
        for (int n = 0; n < 2; ++n)
#pragma unroll
          for (int j = 0; j < 4; ++j) { const float g = acc[ai][0][m][n][j] * r, up = acc[ai][1][m][n][j] * r; o[n * 4 + j] = g * up * __builtin_amdgcn_rcpf(1.0f + __builtin_amdgcn_exp2f(g * -1.4426950408889634f)); }
        if (h8) { u32x2 w; w.x = cvt4_fp8(o[0] * F8_SH, o[1] * F8_SH, o[2] * F8_SH, o[3] * F8_SH); w.y = cvt4_fp8(o[4] * F8_SH, o[5] * F8_SH, o[6] * F8_SH, o[7] * F8_SH); *(u32x2*)((unsigned char*)H + (size_t)row * DFF + col0) = w; }
        else { u32x4 w; w.x = cvt_pk_bf16(o[0], o[1]); w.y = cvt_pk_bf16(o[2], o[3]); w.z = cvt_pk_bf16(o[4], o[5]); w.w = cvt_pk_bf16(o[6], o[7]);
        *(u32x4*)(H + (size_t)row * DFF + col0) = w; }
      }
  }
};
struct EpiY {
  static constexpr bool PERM = true, AFTER_DRAIN = false;
  bf16_t* Y; float* part; float cs;
  __device__ __forceinline__ void operator()(const Acc& acc, const Unit& u, int wr, int wc, int fr, int fq) const {
    const int row0 = u.pm * BM + wr * 64 + fr, col0 = u.pn * BM + wc * 32 + 8 * fq;
#pragma unroll
    for (int ai = 0; ai < 2; ++ai)
#pragma unroll
      for (int m = 0; m < 4; ++m) {
        const int row = row0 + ai * HALF + m * 16; bf16_t* rowp = Y + (size_t)row * DM + col0; float s = 0.f;
#pragma unroll
        for (int bj = 0; bj < 2; ++bj) {
          const f32x4 v0 = acc[ai][bj][m][0] * cs, v1 = acc[ai][bj][m][1] * cs;
          s += (v0[0] * v0[0] + v0[1] * v0[1]) + (v0[2] * v0[2] + v0[3] * v0[3]) + (v1[0] * v1[0] + v1[1] * v1[1]) + (v1[2] * v1[2] + v1[3] * v1[3]);
          u32x4 w; w.x = cvt_pk_bf16(v0[0], v0[1]); w.y = cvt_pk_bf16(v0[2], v0[3]); w.z = cvt_pk_bf16(v1[0], v1[1]); w.w = cvt_pk_bf16(v1[2], v1[3]);
          *(u32x4*)(rowp + bj * HALF) = w;
        }
        s += shfl_xor_f(s, 16); s += shfl_xor_f(s, 32);
        if (fq == 0) part[(size_t)row * 32 + u.pn * 4 + wc] = s;
      }
  }
};
struct EpiRowBf16 {
  static constexpr bool PERM = true, AFTER_DRAIN = false;
  bf16_t* O; int ldc; const float* rs; int act, actcol0;
  __device__ __forceinline__ void operator()(const Acc& acc, const Unit& u, int wr, int wc, int fr, int fq) const {
    const int row0 = u.pm * BM + wr * 64 + fr, col0 = u.pn * BM + wc * 32 + 8 * fq;
    const bool sg = act && (u.pn * BM >= actcol0);
#pragma unroll
    for (int ai = 0; ai < 2; ++ai)
#pragma unroll
      for (int m = 0; m < 4; ++m) {
        const int row = row0 + ai * HALF + m * 16; const float r = rs ? rs[row] : 1.0f; bf16_t* rowp = O + (size_t)row * ldc + col0;
#pragma unroll
        for (int bj = 0; bj < 2; ++bj) {
          f32x4 v0 = acc[ai][bj][m][0] * r, v1 = acc[ai][bj][m][1] * r;
          if (sg) {
#pragma unroll
            for (int j = 0; j < 4; ++j) { v0[j] = __builtin_amdgcn_rcpf(1.0f + __builtin_amdgcn_exp2f(v0[j] * -1.4426950408889634f)); v1[j] = __builtin_amdgcn_rcpf(1.0f + __builtin_amdgcn_exp2f(v1[j] * -1.4426950408889634f)); }
          }
          u32x4 w; w.x = cvt_pk_bf16(v0[0], v0[1]); w.y = cvt_pk_bf16(v0[2], v0[3]); w.z = cvt_pk_bf16(v1[0], v1[1]); w.w = cvt_pk_bf16(v1[2], v1[3]);
          *(u32x4*)(rowp + bj * HALF) = w;
        }
      }
  }
};
struct EpiColBf16 {
  static constexpr bool PERM = true, AFTER_DRAIN = false;
  bf16_t* O; const float* cs; int mode;
  __device__ __forceinline__ void operator()(const Acc& acc, const Unit& u, int wr, int wc, int fr, int fq) const {
    const int row0 = u.pm * BM + wr * 64 + fr, col0 = u.pn * BM + wc * 32 + 8 * fq;
    f32x4 sc[2][2];
#pragma unroll
    for (int bj = 0; bj < 2; ++bj)
#pragma unroll
      for (int n = 0; n < 2; ++n) sc[bj][n] = *(const f32x4*)(cs + col0 + bj * HALF + 4 * n);
#pragma unroll
    for (int ai = 0; ai < 2; ++ai)
#pragma unroll
      for (int m = 0; m < 4; ++m) {
        const int row = row0 + ai * HALF + m * 16;
#pragma unroll
        for (int bj = 0; bj < 2; ++bj) {
          const int col = col0 + bj * HALF;
          size_t off;
          if (mode == 0) off = (size_t)row * 1024 + col;
          else if (row < 3072) off = (size_t)row * NTOK + col;
          else { const int rr = row - 3072, s = rr >> 9, mm = rr & 511, b = col >> 12, l = col & 4095; off = (size_t)3072 * NTOK + ((size_t)((b * 512 + mm) * 2 + s)) * 4096 + l; }
          const f32x4 v0 = acc[ai][bj][m][0] * sc[bj][0], v1 = acc[ai][bj][m][1] * sc[bj][1];
          u32x4 w; w.x = cvt_pk_bf16(v0[0], v0[1]); w.y = cvt_pk_bf16(v0[2], v0[3]); w.z = cvt_pk_bf16(v1[0], v1[1]); w.w = cvt_pk_bf16(v1[2], v1[3]);
          *(u32x4*)(O + off) = w;
        }
      }
  }
};
struct EpiFilt {
  static constexpr bool PERM = false, AFTER_DRAIN = false;
  float* TS;
  __device__ __forceinline__ void operator()(const Acc& acc, const Unit& u, int wr, int wc, int fr, int fq) const {
    const int row0 = u.pm * BM + wr * 64 + fr, col0 = u.pn * BM + wc * 32 + 4 * fq;
    const float min_decay = -3.0701134573f, max_decay = -15.3505672866f;
#pragma unroll
    for (int ai = 0; ai < 2; ++ai)
#pragma unroll
      for (int m = 0; m < 4; ++m) {
        const int row = row0 + ai * HALF + m * 16, ch = row & 1023, dir = (row >> 10) & 1, o = row >> 11;
        const float dl = fabsf(min_decay + (float)ch * ((max_decay - min_decay) / 1023.0f)) * (-1.4426950408889634f / (float)(SEQ - 1));
        float* dst = TS + (size_t)(o * 1024 + ch) * 8192;
#pragma unroll
        for (int bj = 0; bj < 2; ++bj)
#pragma unroll
          for (int n = 0; n < 2; ++n) {
            const int pos = col0 + bj * HALF + n * 16; f32x4 v;
#pragma unroll
            for (int j = 0; j < 4; ++j) v[j] = acc[ai][bj][m][n][j] * __builtin_amdgcn_exp2f((float)(pos + j) * dl) * (1.0f / 8192.0f);
            if (dir == 0) *(f32x4*)(dst + pos) = v;
            else if (pos != 0) { const f32x4 r = {v[3], v[2], v[1], v[0]}; *(f32x4*)(dst + 8192 - pos - 3) = r; }
            else { dst[4096] = 0.f; dst[8191] = v[1]; dst[8190] = v[2]; dst[8189] = v[3]; }
          }
      }
  }
};
template <int W> struct EpiMerge {
  static constexpr bool PERM = false, AFTER_DRAIN = false;
  float* MF; bf16_t* MB; const bf16_t* PN;
  __device__ __forceinline__ void operator()(const Acc& acc, const Unit& u, int wr, int wc, int fr, int fq) const {
    const int row0 = u.pm * BM + wr * 64 + fr, col0 = u.pn * BM + wc * 32 + 4 * fq;
#pragma unroll
    for (int ai = 0; ai < 2; ++ai)
#pragma unroll
      for (int m = 0; m < 4; ++m) {
        const int row = row0 + ai * HALF + m * 16;
#pragma unroll
        for (int bj = 0; bj < 2; ++bj)
#pragma unroll
          for (int n = 0; n < 2; ++n) {
            const int col = col0 + bj * HALF + n * 16;
            const u32x2 gw = *(const u32x2*)(PN + (size_t)row * 6656 + 512 + W * 2048 + col);
            f32x4 g; g[0] = bf2f(gw.x & 0xffffu); g[1] = bf2f(gw.x >> 16); g[2] = bf2f(gw.y & 0xffffu); g[3] = bf2f(gw.y >> 16);
            f32x4 v = acc[ai][bj][m][n] * g;
            float* mp = MF + (size_t)row * DM + col;
            if (W > 0) v += *(const f32x4*)mp;
            if (W < 2) *(f32x4*)mp = v;
            else { u32x2 w; w.x = cvt_pk_bf16(v[0], v[1]); w.y = cvt_pk_bf16(v[2], v[3]); *(u32x2*)(MB + (size_t)row * DM + col) = w; }
          }
      }
  }
};
struct EpiSoftmax {
  static constexpr bool PERM = true, AFTER_DRAIN = true;
  bf16_t* P; float scale_log2e;
  __device__ __forceinline__ void fused(Acc& acc, const Unit& u, int wr, int wc, int fr, int fq, LAS unsigned char* lds, int wid, int lane) const {
    LAS float* RM = (LAS float*)lds;
    LAS float* RS = (LAS float*)(lds + 4096);
    float mx[2][4];
#pragma unroll
    for (int ai = 0; ai < 2; ++ai)
#pragma unroll
      for (int m = 0; m < 4; ++m) {
        float v = -3.0e38f;
#pragma unroll
        for (int bj = 0; bj < 2; ++bj)
#pragma unroll
          for (int n = 0; n < 2; ++n)
#pragma unroll
            for (int j = 0; j < 4; ++j) v = fmaxf(v, acc[ai][bj][m][n][j]);
        v = fmaxf(v, shfl_xor_f(v, 16)); v = fmaxf(v, shfl_xor_f(v, 32));
        if (fq == 0) RM[(ai * HALF + wr * 64 + m * 16 + fr) * 4 + wc] = v;
      }
    __syncthreads();
#pragma unroll
    for (int ai = 0; ai < 2; ++ai)
#pragma unroll
      for (int m = 0; m < 4; ++m) {
        const int r = ai * HALF + wr * 64 + m * 16 + fr;
        const f32x4 q = *(const LAS f32x4*)(RM + r * 4);
        const float mxx = fmaxf(fmaxf(q[0], q[1]), fmaxf(q[2], q[3]));
        float s = 0.f;
#pragma unroll
        for (int bj = 0; bj < 2; ++bj)
#pragma unroll
          for (int n = 0; n < 2; ++n)
#pragma unroll
            for (int j = 0; j < 4; ++j) { const float e = __builtin_amdgcn_exp2f((acc[ai][bj][m][n][j] - mxx) * scale_log2e); acc[ai][bj][m][n][j] = e; s += e; }
        s += shfl_xor_f(s, 16); s += shfl_xor_f(s, 32);
        if (fq == 0) RS[r * 4 + wc] = s;
        mx[ai][m] = 0.f;
      }
    __syncthreads();
    const int row0 = u.pm * BM + wr * 64 + fr, col0 = u.pn * BM + wc * 32 + 8 * fq;
#pragma unroll
    for (int ai = 0; ai < 2; ++ai)
#pragma unroll
      for (int m = 0; m < 4; ++m) {
        const int r = ai * HALF + wr * 64 + m * 16 + fr;
        const f32x4 q = *(const LAS f32x4*)(RS + r * 4);
        const float inv = 1.0f / ((q[0] + q[1]) + (q[2] + q[3]) + mx[ai][m]);
        bf16_t* rowp = P + (size_t)(row0 + ai * HALF + m * 16) * 1024 + col0;
#pragma unroll
        for (int bj = 0; bj < 2; ++bj) {
          const f32x4 v0 = acc[ai][bj][m][0] * inv, v1 = acc[ai][bj][m][1] * inv;
          u32x4 w; w.x = cvt_pk_bf16(v0[0], v0[1]); w.y = cvt_pk_bf16(v0[2], v0[3]); w.z = cvt_pk_bf16(v1[0], v1[1]); w.w = cvt_pk_bf16(v1[2], v1[3]);
          *(u32x4*)(rowp + bj * HALF) = w;
        }
      }
    __syncthreads();
  }
};
}

__device__ __forceinline__ const float* inl(KP p, int i, int l) { return p->in[i] + (size_t)l * p->lsz[i]; }

struct CJob { const float* src; const float* gain; bf16_t* dst; int K, N, lds_, ldd, koff, col0, mode, f8; };
__device__ __forceinline__ bool get_job(KP p, int l, int j, CJob& J) {
  bf16_t* wb = (bf16_t*)p->ws;
  J.gain = nullptr; J.koff = 0; J.col0 = 0; J.mode = 0; J.f8 = 0;
  switch (j) {
    case 0: J.src = inl(p, 3, l); J.gain = inl(p, 2, l); J.dst = wb + O_WGU1 / 2; J.K = 2048; J.N = 11264; J.lds_ = 11264; J.ldd = 2048; J.mode = 1; J.f8 = (l == 1); break;
    case 1: J.src = inl(p, 4, l); J.dst = wb + O_WD1 / 2; J.K = 5632; J.N = 2048; J.lds_ = 2048; J.ldd = 5632; break;
    case 2: J.src = inl(p, 7, l); J.gain = inl(p, 6, l); J.dst = wb + O_WINT / 2; J.K = 2048; J.N = 3072; J.lds_ = 10240; J.ldd = 2048; break;
    case 3: J.src = inl(p, 7, l); J.gain = inl(p, 6, l); J.dst = wb + O_WINN / 2; J.K = 2048; J.N = 6656; J.lds_ = 10240; J.ldd = 2048; J.col0 = 3584; break;
    case 4: J.src = inl(p, 19, l); J.dst = wb + O_WM / 2; J.K = 1024; J.N = 2048; J.lds_ = 2048; J.ldd = 2560; break;
    case 5: J.src = inl(p, 20, l); J.dst = wb + O_WM / 2; J.K = 512; J.N = 2048; J.lds_ = 2048; J.ldd = 2560; J.koff = 1024; break;
    case 6: J.src = inl(p, 20, l); J.dst = wb + O_WM / 2; J.K = 512; J.N = 2048; J.lds_ = 2048; J.ldd = 2560; J.koff = 1536; break;
    case 7: J.src = inl(p, 23, l); J.dst = wb + O_WOUT / 2; J.K = 2048; J.N = 2048; J.lds_ = 2048; J.ldd = 2048; break;
    case 8: J.src = inl(p, 27, l); J.gain = inl(p, 25, l); J.dst = wb + O_WQ / 2; J.K = 2048; J.N = 2048; J.lds_ = 2048; J.ldd = 2048; break;
    case 9: J.src = inl(p, 28, l); J.gain = inl(p, 26, l); J.dst = wb + O_WK / 2; J.K = 2048; J.N = 2048; J.lds_ = 4096; J.ldd = 2048; break;
    case 10: J.src = inl(p, 28, l); J.gain = inl(p, 26, l); J.dst = wb + O_WV / 2; J.K = 2048; J.N = 2048; J.lds_ = 4096; J.ldd = 2048; J.col0 = 2048; break;
    case 11: J.src = inl(p, 29, l); J.dst = wb + O_WO / 2; J.K = 2048; J.N = 2048; J.lds_ = 2048; J.ldd = 2048; break;
    case 12: J.src = inl(p, 32, l); J.gain = inl(p, 31, l); J.dst = wb + O_WGU2 / 2; J.K = 2048; J.N = 11264; J.lds_ = 11264; J.ldd = 2048; J.mode = 1; J.f8 = (l == 1); break;
    case 13: J.src = inl(p, 33, l); J.dst = wb + O_WD2 / 2; J.K = 5632; J.N = 2048; J.lds_ = 2048; J.ldd = 5632; J.f8 = (l == 1); break;
    case 14: J.src = inl(p, 16, l); J.dst = (bf16_t*)(p->ws + O_W4T); J.K = 64; J.N = 4096; J.lds_ = 4096; J.ldd = 256; break;
    default: return false;
  }
  return true;
}

__device__ __forceinline__ void phase_conv(KP p, int l, float* ldsf) {
  const int tid = TIDX();
  {
    int buf = 0;
    const int r = tid >> 5, c4 = (tid & 31) * 4;
    for (int j = 0; j < 15; ++j) {
      CJob J; get_job(p, l, j, J);
      const int nkt = J.K / 64, ntile = nkt * (J.N / 128);
      const float gsc = J.f8 ? F8_SW : 1.0f;
      auto load_tile = [&](f32x4 (&v)[4], int t) {
        const int kt = t % nkt, ntl = t / nkt, k0 = kt * 64, n0 = ntl * 128;
        int scol; if (J.mode == 1) { const int tt = n0 >> 8, h = (n0 >> 7) & 1; scol = h * DFF + tt * 128; } else scol = J.col0 + n0;
        const float* sp = J.src + (size_t)(k0 + r) * J.lds_ + scol + c4;
#pragma unroll
        for (int q = 0; q < 4; ++q) v[q] = __builtin_nontemporal_load((const f32x4*)(sp + (size_t)(16 * q) * J.lds_)); };
      auto process_tile = [&](f32x4 (&v)[4], int t) {
        float* T = ldsf + buf * (64 * 129);
        const int kt = t % nkt, ntl = t / nkt, k0 = kt * 64, n0 = ntl * 128;
#pragma unroll
        for (int q = 0; q < 4; ++q) { const float g = (J.gain ? J.gain[k0 + r + 16 * q] : 1.0f) * gsc; float* d = T + (r + 16 * q) * 129 + c4; d[0] = v[q][0] * g; d[1] = v[q][1] * g; d[2] = v[q][2] * g; d[3] = v[q][3] * g; }
        __syncthreads();
        if (J.f8) {
          const int n = tid >> 2, kc = (tid & 3) * 16;
          float o[16];
#pragma unroll
          for (int i = 0; i < 16; ++i) o[i] = T[(kc + i) * 129 + n];
          u32x4 w; w.x = cvt4_fp8(o[0], o[1], o[2], o[3]); w.y = cvt4_fp8(o[4], o[5], o[6], o[7]); w.z = cvt4_fp8(o[8], o[9], o[10], o[11]); w.w = cvt4_fp8(o[12], o[13], o[14], o[15]);
          *(u32x4*)((unsigned char*)J.dst + (size_t)(n0 + n) * J.ldd + k0 + kc) = w;
        } else {
#pragma unroll
          for (int h = 0; h < 2; ++h) {
            const int id = tid + 512 * h, n = id >> 3, kc = (id & 7) * 8;
            float o[8];
#pragma unroll
            for (int i = 0; i < 8; ++i) o[i] = T[(kc + i) * 129 + n];
            u32x4 w; w.x = cvt_pk_bf16(o[0], o[1]); w.y = cvt_pk_bf16(o[2], o[3]); w.z = cvt_pk_bf16(o[4], o[5]); w.w = cvt_pk_bf16(o[6], o[7]);
            *(u32x4*)(J.dst + (size_t)(n0 + n) * J.ldd + J.koff + k0 + kc) = w;
          }
        }
        buf ^= 1; };
      f32x4 va[4], vb[4];
      int t = BIDX();
      if (t < ntile) load_tile(va, t);
      while (t < ntile) {
        int tn = t + GDIM();
        if (tn < ntile) load_tile(vb, tn);
        process_tile(va, t);
        t = tn; if (t >= ntile) break;
        tn = t + GDIM();
        if (tn < ntile) load_tile(va, tn);
        process_tile(vb, t);
        t = tn;
      }
    }
    __syncthreads();
  }
  {
    const float* win = inl(p, 7, l); const float* gain = inl(p, 6, l); bf16_t* dst = (bf16_t*)p->ws + O_WINT / 2;
    float* tile = ldsf;
    float* ctab = ldsf + 64 * 129;
    if (tid < 128) { const float rv = (float)tid * (1.0f / 128.0f); ctab[tid] = __builtin_amdgcn_cosf(rv); ctab[128 + tid] = __builtin_amdgcn_sinf(rv); }
    const float scale = 0.0013810679f;
    for (int t = BIDX(); t < 256; t += GDIM()) {
      const int kt = t >> 3, g = (t >> 1) & 3, mh = t & 1, k0 = kt * 64;
      __syncthreads();
      for (int e = tid; e < 64 * 32; e += 512) { const int rr = e >> 5, c4 = (e & 31) * 4; const f32x4 v = *(const f32x4*)(win + (size_t)(k0 + rr) * 10240 + 3072 + g * 128 + c4);
        tile[rr * 129 + c4 + 0] = v[0]; tile[rr * 129 + c4 + 1] = v[1]; tile[rr * 129 + c4 + 2] = v[2]; tile[rr * 129 + c4 + 3] = v[3]; }
      __syncthreads();
      const int kk = tid & 63, mg = tid >> 6;
      float ac[8], as[8];
#pragma unroll
      for (int i = 0; i < 8; ++i) { ac[i] = 0.f; as[i] = 0.f; }
      for (int c = 0; c < 128; ++c) {
        const float x = tile[kk * 129 + c];
#pragma unroll
        for (int i = 0; i < 8; ++i) { const int m = mh * 64 + mg * 8 + i; const int ix = (m * c) & 127; ac[i] += x * ctab[ix]; as[i] += x * ctab[128 + ix]; }
      }
      const float gs = gain[k0 + kk] * scale;
#pragma unroll
      for (int i = 0; i < 8; ++i) { const int m = mh * 64 + mg * 8 + i;
        dst[(size_t)(3072 + g * 128 + m) * 2048 + k0 + kk] = f2bf(ac[i] * gs);
        dst[(size_t)(3072 + 512 + g * 128 + m) * 2048 + k0 + kk] = f2bf(as[i] * gs); }
    }
    __syncthreads();
  }
  {
    const float* wp = inl(p, 21, l); const float* ps = inl(p, 22, l); bf16_t* dst = (bf16_t*)p->ws + O_WM / 2;
    for (size_t e = (size_t)BIDX() * 512 + tid; e < (size_t)2048 * 512; e += (size_t)GDIM() * 512) {
      const int d = (int)(e >> 9), kk = (int)(e & 511), g = kk >> 7, c = kk & 127;
      float v = 0.f; if (g == (d >> 9)) v = wp[(size_t)(g * 128 + c) * 512 + (d & 511)] * ps[d];
      dst[(size_t)d * 2560 + 2048 + kk] = f2bf(v);
    }
    { bf16_t* w4t = (bf16_t*)(p->ws + O_W4T); bf16_t* hb = (bf16_t*)(p->ws + O_HIDB);
      for (size_t e = (size_t)BIDX() * 512 + tid; e < (size_t)4096 * 24; e += (size_t)GDIM() * 512) { const int n = (int)(e / 24), c8 = 64 + (int)(e % 24) * 8; const u32x4 z = {0u, 0u, 0u, 0u}; *(u32x4*)(w4t + (size_t)n * 256 + c8) = z; *(u32x4*)(hb + (size_t)n * 256 + c8) = z; } }
  }
}

__device__ __forceinline__ void phase_dftm(KP p, float* ldsf) {
  const int tid = TIDX();
  __syncthreads();
  for (int i = tid; i < 4096; i += 512) ldsf[i] = __builtin_amdgcn_cosf((float)i * (1.0f / 4096.0f));
  __syncthreads();
  bf16_t* D = (bf16_t*)(p->ws + O_DFTM);
  for (size_t e = (size_t)BIDX() * 512 + tid; e < (size_t)4096 * 1024; e += (size_t)GDIM() * 512) {
    const int k = (int)(e >> 10), j0 = (int)(e & 1023) * 8;
    float o[8];
#pragma unroll
    for (int i = 0; i < 8; ++i) { const int j = j0 + i;
      if (j < 4096) o[i] = ldsf[(k * j) & 4095]; else o[i] = -ldsf[((k * (j - 4096)) - 1024) & 4095]; }
    u32x4 w; w.x = cvt_pk_bf16(o[0], o[1]); w.y = cvt_pk_bf16(o[2], o[3]); w.z = cvt_pk_bf16(o[4], o[5]); w.w = cvt_pk_bf16(o[6], o[7]);
    *(u32x4*)(D + (size_t)k * 8192 + j0) = w;
  }
  __syncthreads();
}

__device__ __forceinline__ void phase_prep(KP p) {
  const int lane = TIDX() & 63, gw = (BIDX() * 512 + TIDX()) >> 6, nw = (GDIM() * 512) >> 6;
  for (int row = gw; row < NTOK + MEMROWS; row += nw) {
    const bool isx = row < NTOK; const int r = isx ? row : row - NTOK;
    const float* src = (isx ? p->in[0] : p->in[1]) + (size_t)r * DM;
    f32x4 v[8]; float ss = 0.f;
#pragma unroll
    for (int i = 0; i < 8; ++i) { v[i] = *(const f32x4*)(src + lane * 4 + i * 256); ss += (v[i][0] * v[i][0] + v[i][1] * v[i][1]) + (v[i][2] * v[i][2] + v[i][3] * v[i][3]); }
    ss = wave_sum(ss);
    const float rr = rsqrtf(ss * (1.0f / DM) + RMS_EPS);
    { bf16_t* dst = (bf16_t*)(p->ws + (isx ? O_XB : O_MB)) + (size_t)r * DM;
#pragma unroll
      for (int i = 0; i < 8; ++i) { u32x2 w; w.x = cvt_pk_bf16(v[i][0], v[i][1]); w.y = cvt_pk_bf16(v[i][2], v[i][3]); *(u32x2*)(dst + lane * 4 + i * 256) = w; }
    }
    if (lane == 0) ((float*)(p->ws + (isx ? O_RSTD : O_RSTDM)))[r] = rr;
  }
}

__device__ __forceinline__ void phase_resid(KP p, const float* xsrc, const float* gpost, float wgt, bool out8) {
  const int lane = TIDX() & 63, gw = (BIDX() * 512 + TIDX()) >> 6, nw = (GDIM() * 512) >> 6;
  const bf16_t* Y = (const bf16_t*)(p->ws + A_Y); const float* part = (const float*)(p->ws + O_PART);
  bf16_t* xb = (bf16_t*)(p->ws + O_XB); float* rstd = (float*)(p->ws + O_RSTD);
  for (int row0 = gw; row0 < NTOK; row0 += 2 * nw) {
    const int rowA = row0, rowB = row0 + nw;
    float psA = lane < 32 ? part[(size_t)rowA * 32 + lane] : 0.f, psB = lane < 32 ? part[(size_t)rowB * 32 + lane] : 0.f;
    u32x2 ya[8], yb[8]; f32x4 xa[8], xq[8];
#pragma unroll
    for (int i = 0; i < 8; ++i) { const int c = lane * 4 + i * 256; const size_t oa = (size_t)rowA * DM + c, ob = (size_t)rowB * DM + c;
      ya[i] = __builtin_nontemporal_load((const u32x2*)(Y + oa)); yb[i] = __builtin_nontemporal_load((const u32x2*)(Y + ob)); xa[i] = __builtin_nontemporal_load((const f32x4*)(xsrc + oa)); xq[i] = __builtin_nontemporal_load((const f32x4*)(xsrc + ob)); }
    psA = wave_sum(psA); psB = wave_sum(psB);
    const float rA = rsqrtf(psA * (1.0f / DM) + RMS_EPS) * wgt, rB = rsqrtf(psB * (1.0f / DM) + RMS_EPS) * wgt;
    float ssA = 0.f, ssB = 0.f;
#pragma unroll
    for (int i = 0; i < 8; ++i) { const int c = lane * 4 + i * 256; const f32x4 g = *(const f32x4*)(gpost + c);
      f32x4 y; y[0] = bf2f(ya[i].x & 0xffffu); y[1] = bf2f(ya[i].x >> 16); y[2] = bf2f(ya[i].y & 0xffffu); y[3] = bf2f(ya[i].y >> 16);
      xa[i] = xa[i] + y * g * rA; ssA += (xa[i][0] * xa[i][0] + xa[i][1] * xa[i][1]) + (xa[i][2] * xa[i][2] + xa[i][3] * xa[i][3]);
      y[0] = bf2f(yb[i].x & 0xffffu); y[1] = bf2f(yb[i].x >> 16); y[2] = bf2f(yb[i].y & 0xffffu); y[3] = bf2f(yb[i].y >> 16);
      xq[i] = xq[i] + y * g * rB; ssB += (xq[i][0] * xq[i][0] + xq[i][1] * xq[i][1]) + (xq[i][2] * xq[i][2] + xq[i][3] * xq[i][3]);
      *(f32x4*)(p->out + (size_t)rowA * DM + c) = xa[i]; *(f32x4*)(p->out + (size_t)rowB * DM + c) = xq[i]; }
    ssA = wave_sum(ssA); ssB = wave_sum(ssB);
    const float rrA = rsqrtf(ssA * (1.0f / DM) + RMS_EPS), rrB = rsqrtf(ssB * (1.0f / DM) + RMS_EPS);
    if (out8) {
      unsigned* dA = (unsigned*)(p->ws + O_XB8 + (size_t)rowA * DM); unsigned* dB = (unsigned*)(p->ws + O_XB8 + (size_t)rowB * DM); const float qa = rrA * F8_SA, qb = rrB * F8_SA;
#pragma unroll
      for (int i = 0; i < 8; ++i) { dA[lane + i * 64] = cvt4_fp8(xa[i][0] * qa, xa[i][1] * qa, xa[i][2] * qa, xa[i][3] * qa); dB[lane + i * 64] = cvt4_fp8(xq[i][0] * qb, xq[i][1] * qb, xq[i][2] * qb, xq[i][3] * qb); }
    } else {
#pragma unroll
      for (int i = 0; i < 8; ++i) { u32x2 w; w.x = cvt_pk_bf16(xa[i][0], xa[i][1]); w.y = cvt_pk_bf16(xa[i][2], xa[i][3]); *(u32x2*)(xb + (size_t)rowA * DM + lane * 4 + i * 256) = w;
        w.x = cvt_pk_bf16(xq[i][0], xq[i][1]); w.y = cvt_pk_bf16(xq[i][2], xq[i][3]); *(u32x2*)(xb + (size_t)rowB * DM + lane * 4 + i * 256) = w; }
    }
    if (lane == 0) { rstd[rowA] = rrA; rstd[rowB] = rrB; }
  }
}

__device__ __forceinline__ void phase_hid(KP p, int l) {
  const int lane = TIDX() & 63, gw = (BIDX() * 512 + TIDX()) >> 6, nw = (GDIM() * 512) >> 6;
  const float* w1 = inl(p, 10, l); const float* b1 = inl(p, 11, l); const float* w2 = inl(p, 12, l); const float* b2 = inl(p, 13, l);
  const float* w3 = inl(p, 14, l); const float* b3 = inl(p, 15, l); const float* fq = inl(p, 17, l);
  const float f = fq[lane];
  for (int pos = gw; pos < SEQ; pos += nw) {
    float z = 0.f;
    if (lane == 0) z = (float)pos / (float)(SEQ - 1);
    else if (lane < 33) { const int j = (lane - 1) & 15; const float band = 1e-4f + (float)j * ((15.0f - 1e-4f) / 15.0f);
      const float rev = (float)pos * band * (1.0f / (float)SEQ); z = lane < 17 ? __builtin_amdgcn_cosf(rev) : -__builtin_amdgcn_sinf(rev); }
    float a = b1[lane];
    for (int i = 0; i < 33; ++i) a += __int_as_float(__builtin_amdgcn_readlane(__float_as_int(z), i)) * w1[i * 64 + lane];
    float h = __builtin_amdgcn_sinf(f * a * 0.15915494309189535f);
    a = b2[lane];
    for (int i = 0; i < 64; ++i) a += __int_as_float(__builtin_amdgcn_readlane(__float_as_int(h), i)) * w2[i * 64 + lane];
    h = __builtin_amdgcn_sinf(f * a * 0.15915494309189535f);
    a = b3[lane];
    for (int i = 0; i < 64; ++i) a += __int_as_float(__builtin_amdgcn_readlane(__float_as_int(h), i)) * w3[i * 64 + lane];
    h = __builtin_amdgcn_sinf(f * a * 0.15915494309189535f);
    ((bf16_t*)(p->ws + O_HIDB))[(size_t)pos * 256 + lane] = f2bf(h);
  }
}

__device__ __forceinline__ void phase_filt(KP p, int l, float* ldsf) {
  const int tid = TIDX();
  const float* hid = (const float*)(p->ws + O_HID); const float* fw4 = inl(p, 16, l);
  float* TS = (float*)(p->ws + A_MB16);
  const float min_decay = -3.0701134573f, max_decay = -15.3505672866f;
  for (int tile = BIDX(); tile < 128 * 8; tile += GDIM()) {
    const int pt = tile >> 3, ct = tile & 7, pos0 = pt * 32, col = ct * 512 + tid, q = col >> 10, ch = col & 1023, o = q >> 1, dir = q & 1;
    __syncthreads();
    for (int e = tid; e < 32 * 64; e += 512) ldsf[e] = hid[(size_t)pos0 * 64 + e];
    __syncthreads();
    float acc[32];
#pragma unroll
    for (int i = 0; i < 32; ++i) acc[i] = 0.f;
    for (int i = 0; i < 64; i += 4) {
      const float wa = fw4[(size_t)i * 4096 + col], wb = fw4[(size_t)(i + 1) * 4096 + col], wc = fw4[(size_t)(i + 2) * 4096 + col], wd = fw4[(size_t)(i + 3) * 4096 + col];
#pragma unroll
      for (int pp = 0; pp < 32; ++pp) { const f32x4 h = *(const f32x4*)(ldsf + pp * 64 + i); acc[pp] += h[0] * wa + h[1] * wb + h[2] * wc + h[3] * wd; }
    }
    const float delta = fabsf(min_decay + (float)ch * ((max_decay - min_decay) / 1023.0f));
    float* stage = ldsf + 2048;
#pragma unroll
    for (int pp = 0; pp < 32; ++pp) {
      const int pos = pos0 + pp;
      stage[tid * 33 + pp] = acc[pp] * __expf(-((float)pos / (float)(SEQ - 1)) * delta) * (1.0f / 8192.0f);
    }
    __syncthreads();
    const int jj = tid & 31;
#pragma unroll 4
    for (int it = 0; it < 32; ++it) {
      const int row = it * 16 + (tid >> 5), rcol = ct * 512 + row, rch = rcol & 1023;
      float* dst = TS + (size_t)(o * 1024 + rch) * 8192; const float val = stage[row * 33 + jj]; const int pos = pos0 + jj;
      if (dir == 0) dst[pos] = val; else if (pos == 0) dst[4096] = 0.f; else dst[8192 - pos] = val;
    }
  }
  __syncthreads();
}

__device__ __forceinline__ f32x2 cmul(f32x2 a, f32x2 b) { return (f32x2){a.x * b.x - a.y * b.y, a.x * b.y + a.y * b.x}; }
template <bool INV> __device__ __forceinline__ void dft4(f32x2& a, f32x2& b, f32x2& c, f32x2& d) {
  const f32x2 s0 = a + c, s1 = a - c, s2 = b + d, s3 = b - d;
  const f32x2 js3 = INV ? (f32x2){-s3.y, s3.x} : (f32x2){s3.y, -s3.x};
  a = s0 + s2; c = s0 - s2; b = s1 + js3; d = s1 - js3;
}
#define XI(k) ((((k) & 3) * 4) + ((k) >> 2))
template <bool INV> __device__ __forceinline__ void dft16(f32x2 (&v)[16]) {
#pragma unroll
  for (int b = 0; b < 4; ++b) dft4<INV>(v[b], v[4 + b], v[8 + b], v[12 + b]);
  const float C1 = 0.92387953251f, S1 = 0.38268343236f, R2 = 0.70710678118f;
  const f32x2 W1 = {C1, INV ? S1 : -S1}, W2 = {R2, INV ? R2 : -R2}, W3 = {S1, INV ? C1 : -C1}, W4 = {0.f, INV ? 1.f : -1.f}, W6 = {-R2, INV ? R2 : -R2}, W9 = {-C1, INV ? -S1 : S1};
  v[4 * 1 + 1] = cmul(v[4 * 1 + 1], W1); v[4 * 1 + 2] = cmul(v[4 * 1 + 2], W2); v[4 * 1 + 3] = cmul(v[4 * 1 + 3], W3);
  v[4 * 2 + 1] = cmul(v[4 * 2 + 1], W2); v[4 * 2 + 2] = cmul(v[4 * 2 + 2], W4); v[4 * 2 + 3] = cmul(v[4 * 2 + 3], W6);
  v[4 * 3 + 1] = cmul(v[4 * 3 + 1], W3); v[4 * 3 + 2] = cmul(v[4 * 3 + 2], W6); v[4 * 3 + 3] = cmul(v[4 * 3 + 3], W9);
#pragma unroll
  for (int c = 0; c < 4; ++c) dft4<INV>(v[4 * c + 0], v[4 * c + 1], v[4 * c + 2], v[4 * c + 3]);
}
__device__ __forceinline__ void twiddle16(f32x2 (&v)[16], f32x2 w) {
  asm volatile("" : "+v"(w.x), "+v"(w.y));
  const f32x2 w2 = cmul(w, w), w3 = cmul(w2, w), w4 = cmul(w2, w2), w5 = cmul(w4, w), w6 = cmul(w4, w2), w7 = cmul(w4, w3), w8 = cmul(w4, w4);
  v[XI(1)] = cmul(v[XI(1)], w); v[XI(2)] = cmul(v[XI(2)], w2); v[XI(3)] = cmul(v[XI(3)], w3); v[XI(4)] = cmul(v[XI(4)], w4);
  v[XI(5)] = cmul(v[XI(5)], w5); v[XI(6)] = cmul(v[XI(6)], w6); v[XI(7)] = cmul(v[XI(7)], w7); v[XI(8)] = cmul(v[XI(8)], w8);
  v[XI(9)] = cmul(v[XI(9)], cmul(w8, w)); v[XI(10)] = cmul(v[XI(10)], cmul(w8, w2)); v[XI(11)] = cmul(v[XI(11)], cmul(w8, w3)); v[XI(12)] = cmul(v[XI(12)], cmul(w8, w4));
  v[XI(13)] = cmul(v[XI(13)], cmul(w8, w5)); v[XI(14)] = cmul(v[XI(14)], cmul(w8, w6)); v[XI(15)] = cmul(v[XI(15)], cmul(w8, w7));
}
__device__ __forceinline__ void twiddle16n(f32x2 (&v)[16], f32x2 w) {
  asm volatile("" : "+v"(w.x), "+v"(w.y));
  const f32x2 w2 = cmul(w, w), w3 = cmul(w2, w), w4 = cmul(w2, w2), w5 = cmul(w4, w), w6 = cmul(w4, w2), w7 = cmul(w4, w3), w8 = cmul(w4, w4);
  v[1] = cmul(v[1], w); v[2] = cmul(v[2], w2); v[3] = cmul(v[3], w3); v[4] = cmul(v[4], w4); v[5] = cmul(v[5], w5); v[6] = cmul(v[6], w6); v[7] = cmul(v[7], w7); v[8] = cmul(v[8], w8);
  v[9] = cmul(v[9], cmul(w8, w)); v[10] = cmul(v[10], cmul(w8, w2)); v[11] = cmul(v[11], cmul(w8, w3)); v[12] = cmul(v[12], cmul(w8, w4));
  v[13] = cmul(v[13], cmul(w8, w5)); v[14] = cmul(v[14], cmul(w8, w6)); v[15] = cmul(v[15], cmul(w8, w7));
}
__device__ __forceinline__ int PADI(int i) { return i + (i >> 5); }
__device__ __forceinline__ float dpp_xor1(float x) { return __int_as_float(__builtin_amdgcn_mov_dpp(__float_as_int(x), 0xB1, 0xF, 0xF, true)); }

struct FftCtx { f32x2 w1; int P1, P2, P3, n3, t31;
  __device__ __forceinline__ f32x2 w2f() const { int q = t31; asm volatile("" : "+v"(q)); const float r = -(float)q * (1.0f / 512.0f); return (f32x2){__builtin_amdgcn_cosf(r), __builtin_amdgcn_sinf(r)}; }
  __device__ __forceinline__ f32x2 w3f() const { int q = n3; asm volatile("" : "+v"(q)); const float r = -(float)q * (1.0f / 32.0f); return (f32x2){__builtin_amdgcn_cosf(r), __builtin_amdgcn_sinf(r)}; } };

__device__ __forceinline__ void fft_fwd2(f32x2 (&x)[16], f32x2 (&y)[16], const FftCtx& c, f32x2* bufA, f32x2* bufB) {
  dft16<false>(x); twiddle16(x, c.w1); __builtin_amdgcn_sched_barrier(0); dft16<false>(y); twiddle16(y, c.w1); __builtin_amdgcn_sched_barrier(0);
#pragma unroll
  for (int k = 0; k < 16; ++k) { bufA[c.P1 + k * 528] = x[XI(k)]; bufB[c.P1 + k * 528] = y[XI(k)]; }
  __syncthreads();
#pragma unroll
  for (int n = 0; n < 16; ++n) { x[n] = bufA[c.P2 + n * 33]; y[n] = bufB[c.P2 + n * 33]; }
  dft16<false>(x); twiddle16(x, c.w2f()); __builtin_amdgcn_sched_barrier(0); dft16<false>(y); twiddle16(y, c.w2f()); __builtin_amdgcn_sched_barrier(0);
#pragma unroll
  for (int k = 0; k < 16; ++k) { bufA[c.P2 + k * 33] = x[XI(k)]; bufB[c.P2 + k * 33] = y[XI(k)]; }
  __syncthreads();
#pragma unroll
  for (int n = 0; n < 16; ++n) { x[n] = bufA[c.P3 + n * 2]; y[n] = bufB[c.P3 + n * 2]; }
  dft16<false>(x); twiddle16(x, c.w3f()); __builtin_amdgcn_sched_barrier(0); dft16<false>(y); twiddle16(y, c.w3f()); __builtin_amdgcn_sched_barrier(0);
#pragma unroll
  for (int i = 0; i < 16; ++i) { const f32x2 o = {dpp_xor1(x[i].x), dpp_xor1(x[i].y)}; x[i] = c.n3 ? (o - x[i]) : (x[i] + o);
                                 const f32x2 q = {dpp_xor1(y[i].x), dpp_xor1(y[i].y)}; y[i] = c.n3 ? (q - y[i]) : (y[i] + q); }
}
__device__ __forceinline__ void fft_inv2(f32x2 (&x)[16], f32x2 (&y)[16], const FftCtx& c, f32x2* bufA, f32x2* bufB) {
  f32x2 u[16], w[16];
#pragma unroll
  for (int k = 0; k < 16; ++k) { const f32x2 own = x[XI(k)]; const f32x2 o = {dpp_xor1(own.x), dpp_xor1(own.y)}; u[k] = c.n3 ? (o - own) : (own + o);
                                 const f32x2 owy = y[XI(k)]; const f32x2 q = {dpp_xor1(owy.x), dpp_xor1(owy.y)}; w[k] = c.n3 ? (q - owy) : (owy + q); }
  { const f32x2 q3 = c.w3f(); twiddle16n(u, (f32x2){q3.x, -q3.y}); } dft16<true>(u); __builtin_amdgcn_sched_barrier(0); { const f32x2 q3 = c.w3f(); twiddle16n(w, (f32x2){q3.x, -q3.y}); } dft16<true>(w); __builtin_amdgcn_sched_barrier(0);
#pragma unroll
  for (int n = 0; n < 16; ++n) { bufA[c.P3 + n * 2] = u[XI(n)]; bufB[c.P3 + n * 2] = w[XI(n)]; }
  __syncthreads();
#pragma unroll
  for (int k = 0; k < 16; ++k) { u[k] = bufA[c.P2 + k * 33]; w[k] = bufB[c.P2 + k * 33]; }
  { const f32x2 q2 = c.w2f(); twiddle16n(u, (f32x2){q2.x, -q2.y}); } dft16<true>(u); __builtin_amdgcn_sched_barrier(0); { const f32x2 q2 = c.w2f(); twiddle16n(w, (f32x2){q2.x, -q2.y}); } dft16<true>(w); __builtin_amdgcn_sched_barrier(0);
#pragma unroll
  for (int n = 0; n < 16; ++n) { bufA[c.P2 + n * 33] = u[XI(n)]; bufB[c.P2 + n * 33] = w[XI(n)]; }
  __syncthreads();
#pragma unroll
  for (int k = 0; k < 16; ++k) { u[k] = bufA[c.P1 + k * 528]; w[k] = bufB[c.P1 + k * 528]; }
  twiddle16n(u, (f32x2){c.w1.x, -c.w1.y}); dft16<true>(u); __builtin_amdgcn_sched_barrier(0); twiddle16n(w, (f32x2){c.w1.x, -c.w1.y}); dft16<true>(w); __builtin_amdgcn_sched_barrier(0);
#pragma unroll
  for (int i = 0; i < 16; ++i) { x[i] = u[i]; y[i] = w[i]; }
}

__device__ __forceinline__ float sconv(const bf16_t* col, int l, float w0, float w1, float w2, float cb) {
  const float um = bf2f(col[l - 1]), u0 = bf2f(col[l]), up = bf2f(col[l + 1]);
  return cb + w0 * (l > 0 ? um : 0.f) + w1 * u0 + w2 * (l < SEQ - 1 ? up : 0.f);
}

__device__ __forceinline__ void phase_hyena(KP p, int l, unsigned char* ldsraw) {
  f32x2* bufA = (f32x2*)ldsraw; f32x2* bufB = bufA + 8448;
  const int t = TIDX();
  FftCtx c; c.P1 = t + (t >> 5); c.P2 = (t >> 5) * 528 + (t & 31); c.P3 = (t >> 1) * 33 + (t & 1); c.n3 = t & 1; c.t31 = t & 31;
  { const float r1 = -(float)t * (1.0f / 8192.0f); c.w1 = (f32x2){__builtin_amdgcn_cosf(r1), __builtin_amdgcn_sinf(r1)}; }
  const float* TS = (const float*)(p->ws + A_MB16);
  const float* cw = inl(p, 8, l); const float* cbp = inl(p, 9, l); const float* dsk = inl(p, 18, l);
  const bf16_t* HT = (const bf16_t*)(p->ws + A_HTFT);
  bf16_t* Z2T = (bf16_t*)(p->ws + A_Z2T);
  f32x2* Hs = (f32x2*)(p->ws + A_HST + (size_t)BIDX() * 131072);
  for (int ch = BIDX(); ch < 1024; ch += GDIM()) {
    const float* tsa = TS + (size_t)ch * 8192; const float* tsb = TS + (size_t)(1024 + ch) * 8192;
    f32x2 x[16], y[16];
    { int tt = t; asm volatile("" : "+v"(tt));
#pragma unroll
      for (int i = 0; i < 16; ++i) { x[i] = (f32x2){__builtin_nontemporal_load(tsa + i * 512 + tt), 0.f}; y[i] = (f32x2){__builtin_nontemporal_load(tsb + i * 512 + tt), 0.f}; } }
    fft_fwd2(x, y, c, bufA, bufB);
    { int tt = t; asm volatile("" : "+v"(tt));
#pragma unroll
      for (int k = 0; k < 16; ++k) { Hs[k * 512 + tt] = x[XI(k)]; Hs[8192 + k * 512 + tt] = y[XI(k)]; } }
    float w0[3], w1[3], w2[3], cb[3];
#pragma unroll
    for (int q = 0; q < 3; ++q) { const int col = q * 1024 + ch; w0[q] = cw[col]; w1[q] = cw[3072 + col]; w2[q] = cw[6144 + col]; cb[q] = cbp[col]; }
    const float d1 = dsk[ch], d2 = dsk[1024 + ch];
    const bf16_t* colv = HT + (size_t)ch * NTOK; const bf16_t* colg = HT + (size_t)(1024 + ch) * NTOK; const bf16_t* colh = HT + (size_t)(2048 + ch) * NTOK;
    unsigned zp[8], zq[8];
    { int t1 = t; asm volatile("" : "+v"(t1));
#pragma unroll
      for (int n1 = 0; n1 < 8; ++n1) { const int pos = n1 * 512 + t1;
        zp[n1] = cvt_pk_bf16(sconv(colv, pos, w0[0], w1[0], w2[0], cb[0]), sconv(colv + SEQ, pos, w0[0], w1[0], w2[0], cb[0]));
        zq[n1] = cvt_pk_bf16(sconv(colv + 2 * SEQ, pos, w0[0], w1[0], w2[0], cb[0]), sconv(colv + 3 * SEQ, pos, w0[0], w1[0], w2[0], cb[0])); } }
#pragma unroll
    for (int o = 0; o < 2; ++o) {
      const float dd = o ? d2 : d1; const bf16_t* gc = o ? colh : colg; const int q = 1 + o;
#pragma unroll
      for (int i = 0; i < 8; ++i) { x[i] = (f32x2){bf2f(zp[i] & 0xffffu), bf2f(zp[i] >> 16)}; x[8 + i] = (f32x2){0.f, 0.f}; y[i] = (f32x2){bf2f(zq[i] & 0xffffu), bf2f(zq[i] >> 16)}; y[8 + i] = (f32x2){0.f, 0.f}; }
      fft_fwd2(x, y, c, bufA, bufB);
      { int tt = t; asm volatile("" : "+v"(tt));
#pragma unroll
        for (int k = 0; k < 16; ++k) { const f32x2 hh = Hs[o * 8192 + k * 512 + tt]; x[XI(k)] = cmul(x[XI(k)], hh); y[XI(k)] = cmul(y[XI(k)], hh); } }
      fft_inv2(x, y, c, bufA, bufB);
      { int t2 = t; asm volatile("" : "+v"(t2));
#pragma unroll
        for (int n1 = 0; n1 < 8; ++n1) { const int pos = n1 * 512 + t2; const f32x2 a = x[XI(n1)], b = y[XI(n1)];
          const float r0 = sconv(gc, pos, w0[q], w1[q], w2[q], cb[q]) * (a.x + dd * bf2f(zp[n1] & 0xffffu)), r1 = sconv(gc + SEQ, pos, w0[q], w1[q], w2[q], cb[q]) * (a.y + dd * bf2f(zp[n1] >> 16));
          const float r2 = sconv(gc + 2 * SEQ, pos, w0[q], w1[q], w2[q], cb[q]) * (b.x + dd * bf2f(zq[n1] & 0xffffu)), r3 = sconv(gc + 3 * SEQ, pos, w0[q], w1[q], w2[q], cb[q]) * (b.y + dd * bf2f(zq[n1] >> 16));
          zp[n1] = cvt_pk_bf16(r0, r1); zq[n1] = cvt_pk_bf16(r2, r3); } }
    }
    { bf16_t* o0 = Z2T + (size_t)ch * NTOK; int t3 = t; asm volatile("" : "+v"(t3));
#pragma unroll
      for (int n1 = 0; n1 < 8; ++n1) { o0[n1 * 512 + t3] = (bf16_t)(zp[n1] & 0xffffu); o0[SEQ + n1 * 512 + t3] = (bf16_t)(zp[n1] >> 16); o0[2 * SEQ + n1 * 512 + t3] = (bf16_t)(zq[n1] & 0xffffu); o0[3 * SEQ + n1 * 512 + t3] = (bf16_t)(zq[n1] >> 16); } }
  }
  __syncthreads();
}

__device__ __forceinline__ void phase_poolt(KP p, unsigned char* ldsraw) {
  const int tid = TIDX();
  bf16_t* tl = (bf16_t*)ldsraw;
  const bf16_t* Z2T = (const bf16_t*)(p->ws + A_Z2T); bf16_t* ZC = (bf16_t*)(p->ws + A_ZCAT); const bf16_t* PN = (const bf16_t*)(p->ws + A_PN);
  for (int tile = BIDX(); tile < 16 * 256; tile += GDIM()) {
    const int c0 = (tile & 15) * 64, t0 = (tile >> 4) * 64;
    const int i = tid >> 3, jj = (tid & 7) * 8;
    __syncthreads();
    { const u32x4 w = __builtin_nontemporal_load((const u32x4*)(Z2T + (size_t)(c0 + i) * NTOK + t0 + jj));
      *(u32x4*)(tl + i * 72 + jj) = w; }
    __syncthreads();
    { unsigned e[8];
#pragma unroll
      for (int q = 0; q < 8; ++q) e[q] = tl[(jj + q) * 72 + i];
      u32x4 w; w.x = e[0] | (e[1] << 16); w.y = e[2] | (e[3] << 16); w.z = e[4] | (e[5] << 16); w.w = e[6] | (e[7] << 16);
      *(u32x4*)(ZC + (size_t)(t0 + i) * 2560 + c0 + jj) = w; }
  }
  for (size_t e = (size_t)BIDX() * 512 + tid; e < (size_t)NTOK * 64; e += (size_t)GDIM() * 512) {
    const int tok = (int)(e >> 6), c8 = (int)(e & 63) * 8, g = c8 >> 7, w = 2 << g, before = w >> 1, after = w - 1 - before;
    const int b = tok >> 12, l = tok & 4095;
    int lo = l - before; if (lo < 0) lo = 0; int hi = l + after; if (hi > SEQ - 1) hi = SEQ - 1;
    float s[8];
#pragma unroll
    for (int q = 0; q < 8; ++q) s[q] = 0.f;
    u32x4 wv[16];
#pragma unroll
    for (int j = 0; j < 16; ++j) { int r = l - before + j; r = r < 0 ? 0 : (r > SEQ - 1 ? SEQ - 1 : r); wv[j] = *(const u32x4*)(PN + (size_t)(b * SEQ + r) * 6656 + c8); }
#pragma unroll
    for (int j = 0; j < 16; ++j) { const int r = l - before + j; const float m = (j < w && r >= 0 && r <= SEQ - 1) ? 1.0f : 0.0f;
      s[0] += m * bf2f(wv[j].x & 0xffff); s[1] += m * bf2f(wv[j].x >> 16); s[2] += m * bf2f(wv[j].y & 0xffff); s[3] += m * bf2f(wv[j].y >> 16);
      s[4] += m * bf2f(wv[j].z & 0xffff); s[5] += m * bf2f(wv[j].z >> 16); s[6] += m * bf2f(wv[j].w & 0xffff); s[7] += m * bf2f(wv[j].w >> 16); }
    const u32x4 sv = *(const u32x4*)(PN + (size_t)tok * 6656 + c8);
    const float inv = 1.0f / (float)(hi - lo + 1);
    float o[8];
    o[0] = s[0] * inv - bf2f(sv.x & 0xffff); o[1] = s[1] * inv - bf2f(sv.x >> 16); o[2] = s[2] * inv - bf2f(sv.y & 0xffff); o[3] = s[3] * inv - bf2f(sv.y >> 16);
    o[4] = s[4] * inv - bf2f(sv.z & 0xffff); o[5] = s[5] * inv - bf2f(sv.z >> 16); o[6] = s[6] * inv - bf2f(sv.w & 0xffff); o[7] = s[7] * inv - bf2f(sv.w >> 16);
    u32x4 w4; w4.x = cvt_pk_bf16(o[0], o[1]); w4.y = cvt_pk_bf16(o[2], o[3]); w4.z = cvt_pk_bf16(o[4], o[5]); w4.w = cvt_pk_bf16(o[6], o[7]);
    *(u32x4*)(ZC + (size_t)tok * 2560 + 2048 + c8) = w4;
  }
  __syncthreads();
}

#define XB_TMO      128
#define XB_XCNT(j)  (256  + 64 * (j))
#define XB_XSUB(j)  (1280 + 64 * (j))
#define XB_XGEN(j)  (2304 + 64 * (j))
#define XB_TOP      3328
#define XB_TOPGEN   3392
#define XCD_BAR_WORDS 3456
#define XB_SPIN_CAP (1u << 18)

__device__ __forceinline__ unsigned xb_ld(unsigned* p)              { return __hip_atomic_load(p, __ATOMIC_RELAXED, __HIP_MEMORY_SCOPE_AGENT); }
__device__ __forceinline__ unsigned xb_add(unsigned* p, unsigned v) { return __hip_atomic_fetch_add(p, v, __ATOMIC_RELAXED, __HIP_MEMORY_SCOPE_AGENT); }
__device__ __forceinline__ unsigned xb_xcc_id() { return (unsigned)__builtin_amdgcn_s_getreg((3 << 11) | 20) & 0xFu; }
#define XB_SPIN(cond, bar) do { unsigned _sp = 0; while (cond) { __builtin_amdgcn_s_sleep(1); \
    if ((++_sp & 255u) == 0u) { if (xb_ld(&(bar)[XB_TMO])) break; if (_sp > XB_SPIN_CAP) { atomicAdd(&(bar)[XB_TMO], 1u); break; } } } } while (0)

struct XcdBarrier {
    unsigned* bar; unsigned x;
    volatile LAS unsigned* st;
};

__device__ __forceinline__ XcdBarrier xcd_barrier_post(unsigned* bar, volatile LAS unsigned* st) {
    XcdBarrier b; b.bar = bar; b.x = xb_xcc_id(); b.st = st;
    if (TIDX() == 0) (void)xb_add(&bar[XB_XCNT(b.x)], 1u);
    return b;
}
__device__ __forceinline__ void xcd_barrier_complete(unsigned* bar, unsigned x, unsigned& nloc, unsigned& nx) {
    const unsigned G = (unsigned)GDIM();
    unsigned sum, cnt, mine, sp = 0u;
    for (;;) {
        sum = 0u; cnt = 0u; mine = 0u;
#pragma unroll
        for (unsigned j = 0; j < 16; ++j) { const unsigned c = xb_ld(&bar[XB_XCNT(j)]); sum += c; cnt += (c > 0u) ? 1u : 0u; mine = (j == x) ? c : mine; }
        if (sum == G) break;
        __builtin_amdgcn_s_sleep(1);
        if ((++sp & 255u) == 0u) { if (xb_ld(&bar[XB_TMO])) break; if (sp > XB_SPIN_CAP) { atomicAdd(&bar[XB_TMO], 1u); break; } }
    }
    nloc = mine > 0u ? mine : 1u; nx = cnt > 0u ? cnt : 1u;
}

__device__ __forceinline__ void xcd_barrier(const XcdBarrier& b) {
    asm volatile("s_waitcnt vmcnt(0)" ::: "memory");
    __syncthreads();
    if (TIDX() == 0) {
        unsigned* bar = b.bar; asm volatile("" : "+s"(bar));
        __builtin_amdgcn_s_waitcnt(0);
        unsigned nloc = b.st[0], nx = b.st[1];
        if (nloc == 0u) { xcd_barrier_complete(bar, b.x, nloc, nx); b.st[0] = nloc; b.st[1] = nx; }
        const unsigned old = xb_add(&bar[XB_XSUB(b.x)], 1u);
        const unsigned gen = old / nloc;
        if (old + 1u == (gen + 1u) * nloc) {
            __builtin_amdgcn_fence(__ATOMIC_RELEASE, "agent");
            asm volatile("s_waitcnt vmcnt(0)" ::: "memory");
            const unsigned og = xb_add(&bar[XB_TOP], 1u);
            const unsigned tg = og / nx;
            if (og + 1u == (tg + 1u) * nx) xb_add(&bar[XB_TOPGEN], 1u);
            else XB_SPIN(xb_ld(&bar[XB_TOPGEN]) == tg, bar);
            __builtin_amdgcn_fence(__ATOMIC_ACQUIRE, "agent");
            xb_add(&bar[XB_XGEN(b.x)], 1u);
            asm volatile("s_waitcnt vmcnt(0)" ::: "memory");
        } else {
            XB_SPIN(xb_ld(&bar[XB_XGEN(b.x)]) == gen, bar);
            __builtin_amdgcn_fence(__ATOMIC_ACQUIRE, "agent");
            asm volatile("s_waitcnt vmcnt(0)" ::: "memory");
        }
    }
    __syncthreads();
}


__device__ __forceinline__ void run_phase(KP p, int ph, unsigned char* lds) {
  LAS unsigned char* ldsl = (LAS unsigned char*)lds;
  float* ldsf = (float*)lds;
  pg8::Sched S;
  if (ph == 0) {
    phase_conv(p, 0, ldsf);
    phase_dftm(p, ldsf);
    phase_prep(p);
    phase_hid(p, 0);
    return;
  }
  const int l = (ph - 1) / 17, k = (ph - 1) % 17;
#define WSDEF unsigned char* ws = p->ws; asm volatile("" : "+s"(ws)); bf16_t* wb = (bf16_t*)ws;
  switch (k) {
    case 0: case 14: { WSDEF
      if (l == 1) {
        pg8::EpiSwiGLU E{(bf16_t*)(ws + A_H), nullptr, 1.0f / (F8_SA * F8_SW), k == 14 ? 1 : 0};
        S.init(0, ws + O_XB8, wb + (k == 0 ? O_WGU1 : O_WGU2) / 2, DM / 2, DM / 2, NTOK, 2 * DFF, 0); pg8::gemm_phase<pg8::EpiSwiGLU, true>(ldsl, S, DM / 128, E);
      } else {
        pg8::EpiSwiGLU E{(bf16_t*)(ws + A_H), (const float*)(ws + O_RSTD), 1.0f, 0};
        S.init(0, ws + O_XB, wb + (k == 0 ? O_WGU1 : O_WGU2) / 2, DM, DM, NTOK, 2 * DFF, 0); pg8::gemm_phase(ldsl, S, DM / 64, E);
      } } break;
    case 1: case 15: { WSDEF
      if (k == 15 && l == 1) {
        pg8::EpiY E{(bf16_t*)(ws + A_Y), (float*)(ws + O_PART), 1.0f / (F8_SH * F8_SW)};
        S.init(0, ws + A_H, wb + O_WD2 / 2, DFF / 2, DFF / 2, NTOK, DM, 0); pg8::gemm_phase<pg8::EpiY, true>(ldsl, S, DFF / 128, E);
      } else {
        pg8::EpiY E{(bf16_t*)(ws + A_Y), (float*)(ws + O_PART), 1.0f};
        S.init(0, ws + A_H, wb + (k == 1 ? O_WD1 : O_WD2) / 2, DFF, DFF, NTOK, DM, 0); pg8::gemm_phase(ldsl, S, DFF / 64, E);
      } } break;
    case 2: phase_resid(p, (l == 0) ? p->in[0] : p->out, inl(p, 5, l), 0.5f, false); break;
    case 3: { WSDEF
      { pg8::EpiColBf16 E{(bf16_t*)(ws + A_HTFT), (const float*)(ws + O_RSTD), 1}; S.init(0, wb + O_WINT / 2, ws + O_XB, DM, DM, 4096, NTOK, 0); pg8::gemm_phase(ldsl, S, DM / 64, E); }
      { pg8::EpiRowBf16 E{(bf16_t*)(ws + A_PN), 6656, (const float*)(ws + O_RSTD), 1, 512}; S.init(0, ws + O_XB, wb + O_WINN / 2, DM, DM, NTOK, 6656, 0); pg8::gemm_phase(ldsl, S, DM / 64, E); }
      { pg8::EpiRowBf16 E{(bf16_t*)(ws + O_KB), DM, (const float*)(ws + O_RSTDM), 0, 0}; S.init(0, ws + O_MB, wb + O_WK / 2, DM, DM, MEMROWS, DM, 0); S.c = (S.c + 128) & 255; pg8::gemm_phase(ldsl, S, DM / 64, E); }
      { pg8::EpiColBf16 E{(bf16_t*)(ws + O_VT), (const float*)(ws + O_RSTDM), 0}; S.init(0, wb + O_WV / 2, ws + O_MB, DM, DM, DM, MEMROWS, 0); S.c = (S.c + 96) & 255; pg8::gemm_phase(ldsl, S, DM / 64, E); }
      { pg8::EpiFilt E{(float*)(ws + A_MB16)}; S.init(0, ws + O_W4T, ws + O_HIDB, 256, 256, 4096, 4096, 0); pg8::gemm_phase(ldsl, S, 256 / 64, E); }
    } break;
    case 4: { WSDEF
#ifndef NO_HYENA
      phase_hyena(p, l, lds);
#endif
      pg8::EpiRowBf16 E{(bf16_t*)(ws + A_ZCAT), 2560, nullptr, 0, 0}; S.init(3, ws + O_DFTM, ws + A_HTFT + (size_t)3072 * NTOK * 2, 8192, 8192, 256 * 16, 256 * 16, 0); pg8::gemm_phase(ldsl, S, 4096 / 64, E);
    } break;
    case 5: phase_poolt(p, lds); break;
    case 6: { WSDEF
      float* MF = (float*)(ws + A_MF); bf16_t* MB16 = (bf16_t*)(ws + A_MB16); const bf16_t* PN = (const bf16_t*)(ws + A_PN);
      { pg8::EpiMerge<0> E{MF, MB16, PN}; S.init(0, ws + A_ZCAT, wb + O_WM / 2, 2560, 2560, NTOK, DM, 0); pg8::gemm_phase(ldsl, S, 1024 / 64, E); }
      { pg8::EpiMerge<1> E{MF, MB16, PN}; S.init(0, ws + A_ZCAT, wb + O_WM / 2, 2560, 2560, NTOK, DM, 1024); pg8::gemm_phase(ldsl, S, 1024 / 64, E); }
      { pg8::EpiMerge<2> E{MF, MB16, PN}; S.init(0, ws + A_ZCAT, wb + O_WM / 2, 2560, 2560, NTOK, DM, 2048); pg8::gemm_phase(ldsl, S, 512 / 64, E); }
    } break;
    case 7: case 12: { WSDEF
      pg8::EpiY E{(bf16_t*)(ws + A_Y), (float*)(ws + O_PART), 1.0f};
      S.init(0, ws + (k == 7 ? A_MB16 : A_O), wb + (k == 7 ? O_WOUT : O_WO) / 2, DM, DM, NTOK, DM, 0); pg8::gemm_phase(ldsl, S, DM / 64, E); } break;
    case 8: phase_resid(p, p->out, inl(p, 24, l), 1.0f, false); break;
    case 9: { WSDEF pg8::EpiRowBf16 E{(bf16_t*)(ws + A_Q), DM, (const float*)(ws + O_RSTD), 0, 0}; S.init(0, ws + O_XB, wb + O_WQ / 2, DM, DM, NTOK, DM, 0); pg8::gemm_phase(ldsl, S, DM / 64, E); } break;
    case 10: { WSDEF pg8::EpiSoftmax E{(bf16_t*)(ws + A_P), 0.044194173824159216f * 1.4426950408889634f}; S.init(1, ws + A_Q, ws + O_KB, DM, DM, 256 * 16, 256 * 16, 0); pg8::gemm_phase(ldsl, S, 512 / 64, E); } break;
    case 11: { WSDEF pg8::EpiRowBf16 E{(bf16_t*)(ws + A_O), DM, nullptr, 0, 0}; S.init(2, ws + A_P, ws + O_VT, 1024, 1024, 256 * 32, 256 * 16, 0); pg8::gemm_phase(ldsl, S, 256 / 64, E); } break;
    case 13: phase_resid(p, p->out, inl(p, 30, l), 1.0f, l == 1); break;
    case 16: phase_resid(p, p->out, inl(p, 34, l), 0.5f, l == 0);
#ifndef NO_CONV
      if (l == 0) { phase_conv(p, 1, ldsf); phase_hid(p, 1); }
#endif
      break;
    default: break;
  }
}

__global__ void __launch_bounds__(512, 2) mk_fwd(Params p) {
  unsigned char* lds = g_lds;
  cg::grid_group grid = cg::this_grid();
  volatile LAS unsigned* st = (volatile LAS unsigned*)((LAS unsigned char*)lds + (LDS_BYTES - 16));
  { const int tid0 = (int)threadIdx.x;
    const unsigned hw = (unsigned)__builtin_amdgcn_s_getreg(((6 - 1) << 11) | 4) & 63u;
    if ((tid0 & 63) == 0) *(volatile LAS int*)((LAS unsigned char*)lds + WTAB_OFF + hw * 4) = tid0 >> 6;
    if (tid0 == 0) { st[0] = 0u; st[1] = 0u; } }
  __syncthreads();
  const XcdBarrier xb = xcd_barrier_post((unsigned*)(p.ws + O_BAR), st);
#ifndef REP_K
#define REP_K -1
#endif
  { KP kp = (KP)__builtin_amdgcn_kernarg_segment_ptr(); asm volatile("" : "+s"(kp));
    run_phase(kp, 0, lds); }
  grid.sync();
  for (int ph = 1; ph < 35; ++ph) {
    int nrep = 1;
    if (REP_K >= 0 && REP_K < 17 && (ph - 1) % 17 == REP_K && (REP_K != 2 || ph < 18)) nrep = 2;
    for (int r = 0; r < nrep; ++r) {
      KP kp = (KP)__builtin_amdgcn_kernarg_segment_ptr(); asm volatile("" : "+s"(kp));
      run_phase(kp, ph, lds);
      if (ph != 34 || r != nrep - 1) xcd_barrier(xb);
    }
  }
}

extern "C" void kernel_launch(void* const* d_in, const int* in_sizes, int n_in, void* d_out, int out_size,
                              void* d_ws, size_t ws_size, hipStream_t stream) {
  static int grid_blocks = 0;
  if (!grid_blocks) {
    int dev = 0, cus = 0, per_cu = 0;
    (void)hipGetDevice(&dev);
    (void)hipDeviceGetAttribute(&cus, hipDeviceAttributeMultiprocessorCount, dev);
    (void)hipFuncSetAttribute((const void*)mk_fwd, hipFuncAttributeMaxDynamicSharedMemorySize, LDS_BYTES);
    (void)hipOccupancyMaxActiveBlocksPerMultiprocessor(&per_cu, (const void*)mk_fwd, 512, LDS_BYTES);
    if (per_cu < 1) per_cu = 1;
    grid_blocks = cus * per_cu;
    if (grid_blocks != 256 || ws_size < A_END || n_in != NIN)
      fprintf(stderr, "kernel_launch: unexpected configuration: grid %d (cus %d x %d), ws %zu (need %zu), n_in %d\n", grid_blocks, cus, per_cu, ws_size, (size_t)A_END, n_in);
  }
  (void)hipMemsetAsync((char*)d_ws + O_BAR, 0, 16384, stream);
  Params p{};
  for (int i = 0; i < NIN; ++i) { p.in[i] = (const float*)d_in[i]; p.lsz[i] = in_sizes[i] / 2; }
  p.out = (float*)d_out; p.ws = (unsigned char*)d_ws; p.pad = 0;
  void* args[] = {&p};
  hipError_t e = hipLaunchCooperativeKernel((void*)mk_fwd, dim3(grid_blocks), dim3(512), args, LDS_BYTES, stream);
  if (e != hipSuccess) fprintf(stderr, "cooperative launch failed: %s (grid %d)\n", hipGetErrorString(e), grid_blocks);
}
```

```cpp
#include <hip/hip_runtime.h>
#include <hip/hip_cooperative_groups.h>
#include <cstdio>
namespace cg = cooperative_groups;

#define LAS __attribute__((address_space(3)))
typedef unsigned short bf16_t;
typedef short bf16x8 __attribute__((ext_vector_type(8)));
typedef float f32x4 __attribute__((ext_vector_type(4)));
typedef float f32x2 __attribute__((ext_vector_type(2)));
typedef unsigned u32x4 __attribute__((ext_vector_type(4)));
typedef unsigned u32x2 __attribute__((ext_vector_type(2)));

constexpr int NTOK = 16384, DM = 2048, DFF = 5632, SEQ = 4096, NB = 4, MEMROWS = 1024;
constexpr int NIN = 35;
constexpr float RMS_EPS = 1e-6f;
constexpr float F8_SA = 16.0f, F8_SW = 512.0f, F8_SH = 8.0f;
constexpr int LDS_BYTES = 137216;

constexpr size_t E_WGU = 23068672, E_WD = 11534336, E_WINT = 8388608, E_WINN = 13631488, E_WM = 5242880, E_SQ = 4194304;
constexpr size_t O_WGU1 = 0, O_WD1 = O_WGU1 + 2 * E_WGU, O_WINT = O_WD1 + 2 * E_WD, O_WINN = O_WINT + 2 * E_WINT, O_WM = O_WINN + 2 * E_WINN,
                 O_WOUT = O_WM + 2 * E_WM, O_WQ = O_WOUT + 2 * E_SQ, O_WK = O_WQ + 2 * E_SQ, O_WV = O_WK + 2 * E_SQ, O_WO = O_WV + 2 * E_SQ,
                 O_WGU2 = O_WO + 2 * E_SQ, O_WD2 = O_WGU2 + 2 * E_WGU, O_WEND = O_WD2 + 2 * E_WD;
constexpr size_t O_XB = O_WEND, O_DFTM = O_XB + (size_t)NTOK * DM * 2, O_MB = O_DFTM + (size_t)4096 * 8192 * 2, O_KB = O_MB + (size_t)MEMROWS * DM * 2,
                 O_VT = O_KB + (size_t)MEMROWS * DM * 2, O_HID = O_VT + (size_t)MEMROWS * DM * 2, O_PART = O_HID + (size_t)4096 * 64 * 4,
                 O_RSTD = O_PART + (size_t)NTOK * 32 * 4, O_RSTDM = O_RSTD + (size_t)NTOK * 4, O_BAR = O_RSTDM + 4096, O_ARENA = O_BAR + 16384;
constexpr size_t A_HTFT = O_ARENA, A_PN = A_HTFT + (size_t)4096 * NTOK * 2, A_ZCAT = A_PN + (size_t)NTOK * 6656 * 2, A_MB16 = A_ZCAT + (size_t)NTOK * 2560 * 2,
                 A_HST = A_MB16 + (size_t)NTOK * DM * 2, A_Z2T = A_HST + (size_t)256 * 131072, O_XB8 = A_Z2T + (size_t)1024 * NTOK * 2, O_W4T = O_XB8 + (size_t)NTOK * DM, O_HIDB = O_W4T + (size_t)4096 * 256 * 2, A_END = O_HIDB + (size_t)4096 * 256 * 2;
constexpr size_t A_H = O_ARENA, A_Y = A_PN + (size_t)NTOK * 2560 * 2  , A_MF = A_HTFT, A_Q = O_ARENA, A_P = A_Q + (size_t)NTOK * DM * 2,
                 A_O = A_P + (size_t)NTOK * 1024 * 2;
static_assert(A_Y + (size_t)NTOK * DM * 4 <= A_ZCAT, "y must fit in PN tail");
static_assert(A_O + (size_t)NTOK * DM * 2 <= A_Y, "attention buffers below y");
static_assert(A_H + (size_t)NTOK * DFF * 2 <= A_Y, "H below y");

struct Params {
  const float* in[NIN];
  float* out;
  unsigned char* ws;
  int lsz[NIN];
  int pad;
};

typedef const __attribute__((address_space(4))) Params* KP;
constexpr int WTAB_OFF = LDS_BYTES - 16 - 256;
extern __shared__ __attribute__((aligned(16))) unsigned char g_lds[];
__device__ __forceinline__ int TIDX() {
  int lane; asm volatile("v_mbcnt_lo_u32_b32 %0, -1, 0\n\tv_mbcnt_hi_u32_b32 %0, -1, %0" : "=v"(lane));
  const unsigned hw = (unsigned)__builtin_amdgcn_s_getreg(((6 - 1) << 11) | 4) & 63u;
  const int wave = *(volatile LAS int*)((LAS unsigned char*)g_lds + WTAB_OFF + hw * 4);
  return wave * 64 + lane;
}
__device__ __forceinline__ int BIDX() { int b = __builtin_amdgcn_workgroup_id_x(); asm volatile("" : "+s"(b)); return b; }
__device__ __forceinline__ int GDIM() { int g = (int)__ockl_get_num_groups(0); asm volatile("" : "+s"(g)); return g; }
__device__ __forceinline__ unsigned cvt_pk_bf16(float lo, float hi) { unsigned r; asm("v_cvt_pk_bf16_f32 %0, %1, %2" : "=v"(r) : "v"(lo), "v"(hi)); return r; }
__device__ __forceinline__ unsigned cvt4_fp8(float a, float b, float c, float d) { int w = 0; w = __builtin_amdgcn_cvt_pk_fp8_f32(a, b, w, false); w = __builtin_amdgcn_cvt_pk_fp8_f32(c, d, w, true); return (unsigned)w; }
__device__ __forceinline__ float bf2f(unsigned b) { return __uint_as_float(b << 16); }
__device__ __forceinline__ bf16_t f2bf(float f) { return (bf16_t)(cvt_pk_bf16(f, 0.f) & 0xffffu); }
__device__ __forceinline__ float shfl_xor_f(float v, int m) { const int lane = TIDX() & 63; return __int_as_float(__builtin_amdgcn_ds_bpermute((lane ^ m) << 2, __float_as_int(v))); }
__device__ __forceinline__ float wave_sum(float v) {
  v += __int_as_float(__builtin_amdgcn_ds_swizzle(__float_as_int(v), (16 << 10) | 0x1F));
  v += __int_as_float(__builtin_amdgcn_ds_swizzle(__float_as_int(v), (8 << 10) | 0x1F));
  v += __int_as_float(__builtin_amdgcn_ds_swizzle(__float_as_int(v), (4 << 10) | 0x1F));
  v += __int_as_float(__builtin_amdgcn_ds_swizzle(__float_as_int(v), (2 << 10) | 0x1F));
  v += __int_as_float(__builtin_amdgcn_ds_swizzle(__float_as_int(v), (1 << 10) | 0x1F));
  return __int_as_float(__builtin_amdgcn_readlane(__float_as_int(v), 0)) + __int_as_float(__builtin_amdgcn_readlane(__float_as_int(v), 32));
}

namespace pg8 {
constexpr int BM = 256, BK = 64, HALF = 128, HTB = HALF * BK * 2, STAGE_BYTES = 8 * HTB, NXCD = 8, WGM = 8;
__device__ __forceinline__ int lds_byte(int r, int c) { const int st = (r >> 4) * 2 + (c >> 5), rr = r & 15, cc = c & 31, ob = rr * 64 + cc * 2; return st * 1024 + (ob ^ (((ob >> 9) & 1) << 5)); }
__device__ __forceinline__ void stage_rc(int b, int& R, int& C) { const int st = b / 1024, sb = b % 1024, swz = sb ^ (((sb >> 9) & 1) << 5); R = (st >> 1) * 16 + swz / 64; C = (st & 1) * 32 + (swz % 64) / 2; }
__device__ __forceinline__ int perm32(int rho) { const int n = rho >> 4, i = rho & 15; return 8 * (i >> 2) + 4 * n + (i & 3); }

struct Unit { const char* a; const char* b; int pm, pn; };

struct Sched {
  int mode; const char* A; const char* B; int lda, ldb, nM, nN, nwg, G, c, koff;
  __device__ __forceinline__ void init(int mode_, const void* A_, const void* B_, int lda_, int ldb_, int M, int N, int koff_) {
    mode = mode_; A = (const char*)A_; B = (const char*)B_; lda = lda_; ldb = ldb_; nM = M / BM; nN = N / BM; nwg = nM * nN; G = (int)GDIM(); c = (int)BIDX(); koff = koff_;
  }
  __device__ __forceinline__ bool next(int i, Unit& u) const {
    const long Lq = (long)i * G + c; if (Lq >= nwg) return false;
    int wgid = (int)Lq;
    if (mode == 0) {
      { const int q = nwg / NXCD, r = nwg % NXCD, xcd = wgid % NXCD, off = wgid / NXCD; wgid = (xcd < r ? xcd * (q + 1) : r * (q + 1) + (xcd - r) * q) + off; }
      const int nig = WGM * nN, gid = wgid / nig, fm = gid * WGM, gsz = (nM - fm) < WGM ? (nM - fm) : WGM;
      u.pm = fm + ((wgid % nig) % gsz); u.pn = (wgid % nig) / gsz;
      u.a = A + ((size_t)u.pm * BM * lda + koff) * 2; u.b = B + ((size_t)u.pn * BM * ldb + koff) * 2;
    } else if (mode == 1) {
      const int b = wgid >> 6, h = (wgid >> 4) & 3, qt = wgid & 15;
      u.pm = b * 16 + qt; u.pn = h;
      u.a = A + ((size_t)(b * 4096 + qt * 256) * 2048 + h * 512) * 2; u.b = B + ((size_t)(b * 256) * 2048 + h * 512) * 2;
    } else if (mode == 2) {
      const int dt = wgid & 1, qt = (wgid >> 1) & 15, h = (wgid >> 5) & 3, b = wgid >> 7;
      u.pm = b * 16 + qt; u.pn = h * 2 + dt;
      u.a = A + ((size_t)(b * 4096 + qt * 256) * 1024 + h * 256) * 2; u.b = B + ((size_t)(h * 512 + dt * 256) * 1024 + b * 256) * 2;
    } else {
      const int x = wgid & 7, j = wgid >> 3, b = x >> 1, s = x & 1, kt = j >> 1, mt = j & 1;
      u.pm = b * 16 + kt; u.pn = 4 + s * 2 + mt;
      u.a = A + ((size_t)(kt * 256) * 8192 + s * 4096) * 2; u.b = B + ((size_t)(b * 512 + mt * 256) * 8192 + s * 4096) * 2;
    }
    return true;
  }
};

typedef int i32x4v __attribute__((ext_vector_type(4)));
typedef int i32x8v __attribute__((ext_vector_type(8)));
template <class Epi, bool F8 = false>
__device__ __forceinline__ void gemm_phase(LAS unsigned char* lds, const Sched& S, int nt, const Epi& E) {
    int tid = TIDX(); asm volatile("" : "+v"(tid));
    const int wid = __builtin_amdgcn_readfirstlane(tid >> 6), lane = tid & 63, wr = wid >> 2, wc = wid & 3, fr = lane & 15, fq = lane >> 4;
    unsigned voffA[1], voffB[1];
    { int R, C; stage_rc(tid * 16, R, C); const int Rb = Epi::PERM ? ((R & ~31) + perm32(R & 31)) : R;
        voffA[0] = (unsigned)(R * S.lda + C) * 2u; voffB[0] = (unsigned)(Rb * S.ldb + C) * 2u; }
    const size_t qstepA = (size_t)64 * S.lda * 2, qstepB = (size_t)64 * S.ldb * 2;
    const size_t kstep = (size_t)(BK * 2);
    const size_t hstepA = (size_t)HALF * S.lda * 2, hstepB = (size_t)HALF * S.ldb * 2;
    const unsigned ldsw = (unsigned)wid * 1024u;
    const int aoff = lds_byte(wr * 64 + fr, fq * 8), boff = lds_byte(wc * 32 + fr, fq * 8);
#define PG8_SA(b, h) (((b) * 2 + (h)) * HTB)
#define PG8_SB(b, h) ((4 + (b) * 2 + (h)) * HTB)
#define PG8_STAGE(bufoff, gbase, voff) do { _Pragma("unroll") for (int _i = 0; _i < 2; ++_i) \
        __builtin_amdgcn_global_load_lds((const unsigned*)((const char*)(gbase) + (size_t)_i * q##voff + (voff)[0]), (LAS unsigned*)(lds + (bufoff) + ldsw + _i * 8192), 16, 0, 0); } while (0)
#define qvoffA qstepA
#define qvoffB qstepB
#define PG8_LDA(dst, b, h) do { if constexpr (F8) { _Pragma("unroll") for (int m = 0; m < 4; ++m) dst##8[m] = __builtin_shufflevector(*(const LAS i32x4v*)(lds + PG8_SA(b, h) + aoff + m * 2048), *(const LAS i32x4v*)(lds + PG8_SA(b, h) + aoff + m * 2048 + 1024), 0, 1, 2, 3, 4, 5, 6, 7); } \
        else { _Pragma("unroll") for (int m = 0; m < 4; ++m) _Pragma("unroll") for (int k = 0; k < 2; ++k) dst[m][k] = *(const LAS bf16x8*)(lds + PG8_SA(b, h) + aoff + m * 2048 + k * 1024); } } while (0)
#define PG8_LDB(dst, b, h) do { if constexpr (F8) { _Pragma("unroll") for (int n = 0; n < 2; ++n) dst##8[n] = __builtin_shufflevector(*(const LAS i32x4v*)(lds + PG8_SB(b, h) + boff + n * 2048), *(const LAS i32x4v*)(lds + PG8_SB(b, h) + boff + n * 2048 + 1024), 0, 1, 2, 3, 4, 5, 6, 7); } \
        else { _Pragma("unroll") for (int n = 0; n < 2; ++n) _Pragma("unroll") for (int k = 0; k < 2; ++k) dst[n][k] = *(const LAS bf16x8*)(lds + PG8_SB(b, h) + boff + n * 2048 + k * 1024); } } while (0)
#define PG8_MMA(ai, bj, At, Bt) do { __builtin_amdgcn_s_setprio(1); \
        if constexpr (F8) { _Pragma("unroll") for (int m = 0; m < 4; ++m) _Pragma("unroll") for (int n = 0; n < 2; ++n) \
            asm volatile("v_mfma_scale_f32_16x16x128_f8f6f4 %0, %1, %2, %0, %3, %3 op_sel_hi:[0,0,0]" : "+v"(acc[ai][bj][m][n]) : "v"(Bt##8[n]), "v"(At##8[m]), "v"(f8scale)); } \
        else { _Pragma("unroll") for (int m = 0; m < 4; ++m) _Pragma("unroll") for (int n = 0; n < 2; ++n) _Pragma("unroll") for (int k = 0; k < 2; ++k) \
            acc[ai][bj][m][n] = __builtin_amdgcn_mfma_f32_16x16x32_bf16(Bt[n][k], At[m][k], acc[ai][bj][m][n], 0, 0, 0); } \
        __builtin_amdgcn_s_setprio(0); } while (0)
#define PG8_WAIT_V(n) asm volatile("s_waitcnt vmcnt(" #n ")" ::: "memory")
#define PG8_WAIT_L(n) asm volatile("s_waitcnt lgkmcnt(" #n ")" ::: "memory")
#define PG8_BAR __builtin_amdgcn_s_barrier()
#define PG8_SCHED __builtin_amdgcn_sched_barrier(0)
    Unit cur, nxt; int ui = 0;
    if (!S.next(0, cur)) return;
    f32x4 acc[2][2][4][2];
#pragma unroll
    for (int a = 0; a < 2; ++a)
#pragma unroll
        for (int b = 0; b < 2; ++b)
#pragma unroll
            for (int m = 0; m < 4; ++m)
#pragma unroll
                for (int n = 0; n < 2; ++n) acc[a][b][m][n] = (f32x4){0.f, 0.f, 0.f, 0.f};
    bf16x8 At[4][2], B0[2][2], B1[2][2]; i32x8v At8[4], B08[2], B18[2]; const int f8scale = 0x7f7f7f7f;
    const char* cA = cur.a; const char* cB = cur.b;
    PG8_STAGE(PG8_SB(0, 0), cB, voffB); PG8_STAGE(PG8_SA(0, 0), cA, voffA); PG8_STAGE(PG8_SB(0, 1), cB + hstepB, voffB); PG8_STAGE(PG8_SA(0, 1), cA + hstepA, voffA);
    if (wr == 1) PG8_BAR;
    PG8_WAIT_V(4); PG8_BAR;
    PG8_STAGE(PG8_SB(1, 0), cB + kstep, voffB); PG8_STAGE(PG8_SA(1, 0), cA + kstep, voffA); PG8_STAGE(PG8_SB(1, 1), cB + hstepB + kstep, voffB);
    PG8_WAIT_V(6); PG8_BAR;
    for (;;) {
        const bool has_next = S.next(ui + 1, nxt);
        const char* nA = has_next ? nxt.a : cA; const char* nB = has_next ? nxt.b : cB;
        for (int t = 0; t < nt; t += 2) {
            const bool last = (t == nt - 2);
            const char* a1 = cA + (size_t)(t + 1) * kstep;
            const char* a2 = last ? nA : cA + (size_t)(t + 2) * kstep; const char* b2 = last ? nB : cB + (size_t)(t + 2) * kstep;
            const char* a3 = a2 + kstep; const char* b3 = b2 + kstep;
            PG8_LDB(B0, 0, 0); PG8_SCHED; PG8_LDA(At, 0, 0); PG8_STAGE(PG8_SA(1, 1), a1 + hstepA, voffA);
            PG8_WAIT_L(8); PG8_BAR; PG8_WAIT_L(0); PG8_MMA(0, 0, At, B0); PG8_BAR; PG8_SCHED;
            PG8_LDB(B1, 0, 1); PG8_STAGE(PG8_SB(0, 0), b2, voffB);
            PG8_BAR; PG8_WAIT_L(0); PG8_MMA(0, 1, At, B1); PG8_BAR;
            PG8_LDA(At, 0, 1); PG8_STAGE(PG8_SA(0, 0), a2, voffA);
            PG8_BAR; PG8_WAIT_L(0); PG8_MMA(1, 0, At, B0); PG8_BAR; PG8_SCHED;
            PG8_STAGE(PG8_SB(0, 1), b2 + hstepB, voffB);
            PG8_WAIT_V(6); PG8_BAR; PG8_MMA(1, 1, At, B1); PG8_BAR;
            PG8_LDB(B0, 1, 0); PG8_SCHED; PG8_LDA(At, 1, 0); PG8_STAGE(PG8_SA(0, 1), a2 + hstepA, voffA);
            PG8_WAIT_L(8); PG8_BAR; PG8_WAIT_L(0); PG8_MMA(0, 0, At, B0); PG8_BAR; PG8_SCHED;
            PG8_LDB(B1, 1, 1); PG8_STAGE(PG8_SB(1, 0), b3, voffB);
            PG8_BAR; PG8_WAIT_L(0); PG8_MMA(0, 1, At, B1); PG8_BAR;
            PG8_LDA(At, 1, 1); PG8_STAGE(PG8_SA(1, 0), a3, voffA);
            PG8_BAR; PG8_WAIT_L(0); PG8_MMA(1, 0, At, B0); PG8_BAR; PG8_SCHED;
            PG8_STAGE(PG8_SB(1, 1), b3 + hstepB, voffB);
            PG8_WAIT_V(6); PG8_BAR; PG8_MMA(1, 1, At, B1); PG8_BAR;
        }
        if constexpr (F8) { asm volatile("s_nop 15\n\ts_nop 15\n\ts_nop 15\n\ts_nop 15" ::: "memory"); }
        if constexpr (!Epi::AFTER_DRAIN) { E(acc, cur, wr, wc, fr, fq); }
        if (!has_next) break;
#pragma unroll
        for (int a = 0; a < 2; ++a)
#pragma unroll
            for (int b = 0; b < 2; ++b)
#pragma unroll
                for (int m = 0; m < 4; ++m)
#pragma unroll
                    for (int n = 0; n < 2; ++n) acc[a][b][m][n] = (f32x4){0.f, 0.f, 0.f, 0.f};
        cur = nxt; cA = nA; cB = nB; ++ui;
    }
    PG8_WAIT_V(0);
    if (wr == 0) PG8_BAR;
    PG8_BAR;
    if constexpr (Epi::AFTER_DRAIN) { E.fused(acc, cur, wr, wc, fr, fq, lds, wid, lane); }
#undef PG8_SA
#undef PG8_SB
#undef PG8_STAGE
#undef qvoffA
#undef qvoffB
#undef PG8_LDA
#undef PG8_LDB
#undef PG8_MMA
#undef PG8_WAIT_V
#undef PG8_WAIT_L
#undef PG8_BAR
#undef PG8_SCHED
}

typedef f32x4 Acc[2][2][4][2];

struct EpiSwiGLU {
  static constexpr bool PERM = true, AFTER_DRAIN = false;
  bf16_t* H; const float* rs; float cscale; int h8;
  __device__ __forceinline__ void operator()(const Acc& acc, const Unit& u, int wr_, int wc_, int fr_, int fq_) const {
    const int tid_ = TIDX(), lane_ = tid_ & 63, wid_ = tid_ >> 6, wr = wid_ >> 2, wc = wid_ & 3, fr = lane_ & 15, fq = lane_ >> 4;
    const int row0 = u.pm * BM + wr * 64 + fr, col0 = u.pn * 128 + wc * 32 + 8 * fq;
#pragma unroll
    for (int ai = 0; ai < 2; ++ai)
#pragma unroll
      for (int m = 0; m < 4; ++m) {
        const int row = row0 + ai * HALF + m * 16; const float r = rs ? rs[row] : cscale;
        float o[8];
#pragma unroll
        for (int n = 0; n < 2; ++n)
#pragma unroll
          for (int j = 0; j < 4; ++j) { const float g = acc[ai][0][m][n][j] * r, up = acc[ai][1][m][n][j] * r; o[n * 4 + j] = g * up * __builtin_amdgcn_rcpf(1.0f + __builtin_amdgcn_exp2f(g * -1.4426950408889634f)); }
        if (h8) { u32x2 w; w.x = cvt4_fp8(o[0] * F8_SH, o[1] * F8_SH, o[2] * F8_SH, o[3] * F8_SH); w.y = cvt4_fp8(o[4] * F8_SH, o[5] * F8_SH, o[6] * F8_SH, o[7] * F8_SH); *(u32x2*)((unsigned char*)H + (size_t)row * DFF + col0) = w; }
        else { u32x4 w; w.x = cvt_pk_bf16(o[0], o[1]); w.y = cvt_pk_bf16(o[2], o[3]); w.z = cvt_pk_bf16(o[4], o[5]); w.w = cvt_pk_bf16(o[6], o[7]);
        *(u32x4*)(H + (size_t)row * DFF + col0) = w; }
      }
  }
};
struct EpiY {
  static constexpr bool PERM = true, AFTER_DRAIN = false;
  bf16_t* Y; float* part; float cs;
  __device__ __forceinline__ void operator()(const Acc& acc, const Unit& u, int wr, int wc, int fr, int fq) const {
    const int row0 = u.pm * BM + wr * 64 + fr, col0 = u.pn * BM + wc * 32 + 8 * fq;
#pragma unroll
    for (int ai = 0; ai < 2; ++ai)
#pragma unroll
      for (int m = 0; m < 4; ++m) {
        const int row = row0 + ai * HALF + m * 16; bf16_t* rowp = Y + (size_t)row * DM + col0; float s = 0.f;
#pragma unroll
        for (int bj = 0; bj < 2; ++bj) {
          const f32x4 v0 = acc[ai][bj][m][0] * cs, v1 = acc[ai][bj][m][1] * cs;
          s += (v0[0] * v0[0] + v0[1] * v0[1]) + (v0[2] * v0[2] + v0[3] * v0[3]) + (v1[0] * v1[0] + v1[1] * v1[1]) + (v1[2] * v1[2] + v1[3] * v1[3]);
          u32x4 w; w.x = cvt_pk_bf16(v0[0], v0[1]); w.y = cvt_pk_bf16(v0[2], v0[3]); w.z = cvt_pk_bf16(v1[0], v1[1]); w.w = cvt_pk_bf16(v1[2], v1[3]);
          *(u32x4*)(rowp + bj * HALF) = w;
        }
        s += shfl_xor_f(s, 16); s += shfl_xor_f(s, 32);
        if (fq == 0) part[(size_t)row * 32 + u.pn * 4 + wc] = s;
      }
  }
};
struct EpiRowBf16 {
  static constexpr bool PERM = true, AFTER_DRAIN = false;
  bf16_t* O; int ldc; const float* rs; int act, actcol0;
  __device__ __forceinline__ void operator()(const Acc& acc, const Unit& u, int wr, int wc, int fr, int fq) const {
    const int row0 = u.pm * BM + wr * 64 + fr, col0 = u.pn * BM + wc * 32 + 8 * fq;
    const bool sg = act && (u.pn * BM >= actcol0);
#pragma unroll
    for (int ai = 0; ai < 2; ++ai)
#pragma unroll
      for (int m = 0; m < 4; ++m) {
        const int row = row0 + ai * HALF + m * 16; const float r = rs ? rs[row] : 1.0f; bf16_t* rowp = O + (size_t)row * ldc + col0;
#pragma unroll
        for (int bj = 0; bj < 2; ++bj) {
          f32x4 v0 = acc[ai][bj][m][0] * r, v1 = acc[ai][bj][m][1] * r;
          if (sg) {
#pragma unroll
            for (int j = 0; j < 4; ++j) { v0[j] = __builtin_amdgcn_rcpf(1.0f + __builtin_amdgcn_exp2f(v0[j] * -1.4426950408889634f)); v1[j] = __builtin_amdgcn_rcpf(1.0f + __builtin_amdgcn_exp2f(v1[j] * -1.4426950408889634f)); }
          }
          u32x4 w; w.x = cvt_pk_bf16(v0[0], v0[1]); w.y = cvt_pk_bf16(v0[2], v0[3]); w.z = cvt_pk_bf16(v1[0], v1[1]); w.w = cvt_pk_bf16(v1[2], v1[3]);
          *(u32x4*)(rowp + bj * HALF) = w;
        }
      }
  }
};
struct EpiColBf16 {
  static constexpr bool PERM = true, AFTER_DRAIN = false;
  bf16_t* O; const float* cs; int mode;
  __device__ __forceinline__ void operator()(const Acc& acc, const Unit& u, int wr, int wc, int fr, int fq) const {
    const int row0 = u.pm * BM + wr * 64 + fr, col0 = u.pn * BM + wc * 32 + 8 * fq;
    f32x4 sc[2][2];
#pragma unroll
    for (int bj = 0; bj < 2; ++bj)
#pragma unroll
      for (int n = 0; n < 2; ++n) sc[bj][n] = *(const f32x4*)(cs + col0 + bj * HALF + 4 * n);
#pragma unroll
    for (int ai = 0; ai < 2; ++ai)
#pragma unroll
      for (int m = 0; m < 4; ++m) {
        const int row = row0 + ai * HALF + m * 16;
#pragma unroll
        for (int bj = 0; bj < 2; ++bj) {
          const int col = col0 + bj * HALF;
          size_t off;
          if (mode == 0) off = (size_t)row * 1024 + col;
          else if (row < 3072) off = (size_t)row * NTOK + col;
          else { const int rr = row - 3072, s = rr >> 9, mm = rr & 511, b = col >> 12, l = col & 4095; off = (size_t)3072 * NTOK + ((size_t)((b * 512 + mm) * 2 + s)) * 4096 + l; }
          const f32x4 v0 = acc[ai][bj][m][0] * sc[bj][0], v1 = acc[ai][bj][m][1] * sc[bj][1];
          u32x4 w; w.x = cvt_pk_bf16(v0[0], v0[1]); w.y = cvt_pk_bf16(v0[2], v0[3]); w.z = cvt_pk_bf16(v1[0], v1[1]); w.w = cvt_pk_bf16(v1[2], v1[3]);
          *(u32x4*)(O + off) = w;
        }
      }
  }
};
struct EpiFilt {
  static constexpr bool PERM = false, AFTER_DRAIN = false;
  float* TS;
  __device__ __forceinline__ void operator()(const Acc& acc, const Unit& u, int wr, int wc, int fr, int fq) const {
    const int row0 = u.pm * BM + wr * 64 + fr, col0 = u.pn * BM + wc * 32 + 4 * fq;
    const float min_decay = -3.0701134573f, max_decay = -15.3505672866f;
#pragma unroll
    for (int ai = 0; ai < 2; ++ai)
#pragma unroll
      for (int m = 0; m < 4; ++m) {
        const int row = row0 + ai * HALF + m * 16, ch = row & 1023, dir = (row >> 10) & 1, o = row >> 11;
        const float dl = fabsf(min_decay + (float)ch * ((max_decay - min_decay) / 1023.0f)) * (-1.4426950408889634f / (float)(SEQ - 1));
        float* dst = TS + (size_t)(o * 1024 + ch) * 8192;
#pragma unroll
        for (int bj = 0; bj < 2; ++bj)
#pragma unroll
          for (int n = 0; n < 2; ++n) {
            const int pos = col0 + bj * HALF + n * 16; f32x4 v;
#pragma unroll
            for (int j = 0; j < 4; ++j) v[j] = acc[ai][bj][m][n][j] * __builtin_amdgcn_exp2f((float)(pos + j) * dl) * (1.0f / 8192.0f);
            if (dir == 0) *(f32x4*)(dst + pos) = v;
            else if (pos != 0) { const f32x4 r = {v[3], v[2], v[1], v[0]}; *(f32x4*)(dst + 8192 - pos - 3) = r; }
            else { dst[4096] = 0.f; dst[8191] = v[1]; dst[8190] = v[2]; dst[8189] = v[3]; }
          }
      }
  }
};
template <int W> struct EpiMerge {
  static constexpr bool PERM = false, AFTER_DRAIN = false;
  float* MF; bf16_t* MB; const bf16_t* PN;
  __device__ __forceinline__ void operator()(const Acc& acc, const Unit& u, int wr, int wc, int fr, int fq) const {
    const int row0 = u.pm * BM + wr * 64 + fr, col0 = u.pn * BM + wc * 32 + 4 * fq;
#pragma unroll
    for (int ai = 0; ai < 2; ++ai)
#pragma unroll
      for (int m = 0; m < 4; ++m) {
        const int row = row0 + ai * HALF + m * 16;
#pragma unroll
        for (int bj = 0; bj < 2; ++bj)
#pragma unroll
          for (int n = 0; n < 2; ++n) {
            const int col = col0 + bj * HALF + n * 16;
            const u32x2 gw = *(const u32x2*)(PN + (size_t)row * 6656 + 512 + W * 2048 + col);
            f32x4 g; g[0] = bf2f(gw.x & 0xffffu); g[1] = bf2f(gw.x >> 16); g[2] = bf2f(gw.y & 0xffffu); g[3] = bf2f(gw.y >> 16);
            f32x4 v = acc[ai][bj][m][n] * g;
            float* mp = MF + (size_t)row * DM + col;
            if (W > 0) v += *(const f32x4*)mp;
            if (W < 2) *(f32x4*)mp = v;
            else { u32x2 w; w.x = cvt_pk_bf16(v[0], v[1]); w.y = cvt_pk_bf16(v[2], v[3]); *(u32x2*)(MB + (size_t)row * DM + col) = w; }
          }
      }
  }
};
struct EpiSoftmax {
  static constexpr bool PERM = true, AFTER_DRAIN = true;
  bf16_t* P; float scale_log2e;
  __device__ __forceinline__ void fused(Acc& acc, const Unit& u, int wr, int wc, int fr, int fq, LAS unsigned char* lds, int wid, int lane) const {
    LAS float* RM = (LAS float*)lds;
    LAS float* RS = (LAS float*)(lds + 4096);
    float mx[2][4];
#pragma unroll
    for (int ai = 0; ai < 2; ++ai)
#pragma unroll
      for (int m = 0; m < 4; ++m) {
        float v = -3.0e38f;
#pragma unroll
        for (int bj = 0; bj < 2; ++bj)
#pragma unroll
          for (int n = 0; n < 2; ++n)
#pragma unroll
            for (int j = 0; j < 4; ++j) v = fmaxf(v, acc[ai][bj][m][n][j]);
        v = fmaxf(v, shfl_xor_f(v, 16)); v = fmaxf(v, shfl_xor_f(v, 32));
        if (fq == 0) RM[(ai * HALF + wr * 64 + m * 16 + fr) * 4 + wc] = v;
      }
    __syncthreads();
#pragma unroll
    for (int ai = 0; ai < 2; ++ai)
#pragma unroll
      for (int m = 0; m < 4; ++m) {
        const int r = ai * HALF + wr * 64 + m * 16 + fr;
        const f32x4 q = *(const LAS f32x4*)(RM + r * 4);
        const float mxx = fmaxf(fmaxf(q[0], q[1]), fmaxf(q[2], q[3]));
        float s = 0.f;
#pragma unroll
        for (int bj = 0; bj < 2; ++bj)
#pragma unroll
          for (int n = 0; n < 2; ++n)
#pragma unroll
            for (int j = 0; j < 4; ++j) { const float e = __builtin_amdgcn_exp2f((acc[ai][bj][m][n][j] - mxx) * scale_log2e); acc[ai][bj][m][n][j] = e; s += e; }
        s += shfl_xor_f(s, 16); s += shfl_xor_f(s, 32);
        if (fq == 0) RS[r * 4 + wc] = s;
        mx[ai][m] = 0.f;
      }
    __syncthreads();
    const int row0 = u.pm * BM + wr * 64 + fr, col0 = u.pn * BM + wc * 32 + 8 * fq;
#pragma unroll
    for (int ai = 0; ai < 2; ++ai)
#pragma unroll
      for (int m = 0; m < 4; ++m) {
        const int r = ai * HALF + wr * 64 + m * 16 + fr;
        const f32x4 q = *(const LAS f32x4*)(RS + r * 4);
        const float inv = 1.0f / ((q[0] + q[1]) + (q[2] + q[3]) + mx[ai][m]);
        bf16_t* rowp = P + (size_t)(row0 + ai * HALF + m * 16) * 1024 + col0;
#pragma unroll
        for (int bj = 0; bj < 2; ++bj) {
          const f32x4 v0 = acc[ai][bj][m][0] * inv, v1 = acc[ai][bj][m][1] * inv;
          u32x4 w; w.x = cvt_pk_bf16(v0[0], v0[1]); w.y = cvt_pk_bf16(v0[2], v0[3]); w.z = cvt_pk_bf16(v1[0], v1[1]); w.w = cvt_pk_bf16(v1[2], v1[3]);
          *(u32x4*)(rowp + bj * HALF) = w;
        }
      }
    __syncthreads();
  }
};
}

__device__ __forceinline__ const float* inl(KP p, int i, int l) { return p->in[i] + (size_t)l * p->lsz[i]; }

struct CJob { const float* src; const float* gain; bf16_t* dst; int K, N, lds_, ldd, koff, col0, mode, f8; };
__device__ __forceinline__ bool get_job(KP p, int l, int j, CJob& J) {
  bf16_t* wb = (bf16_t*)p->ws;
  J.gain = nullptr; J.koff = 0; J.col0 = 0; J.mode = 0; J.f8 = 0;
  switch (j) {
    case 0: J.src = inl(p, 3, l); J.gain = inl(p, 2, l); J.dst = wb + O_WGU1 / 2; J.K = 2048; J.N = 11264; J.lds_ = 11264; J.ldd = 2048; J.mode = 1; J.f8 = (l == 1); break;
    case 1: J.src = inl(p, 4, l); J.dst = wb + O_WD1 / 2; J.K = 5632; J.N = 2048; J.lds_ = 2048; J.ldd = 5632; break;
    case 2: J.src = inl(p, 7, l); J.gain = inl(p, 6, l); J.dst = wb + O_WINT / 2; J.K = 2048; J.N = 3072; J.lds_ = 10240; J.ldd = 2048; break;
    case 3: J.src = inl(p, 7, l); J.gain = inl(p, 6, l); J.dst = wb + O_WINN / 2; J.K = 2048; J.N = 6656; J.lds_ = 10240; J.ldd = 2048; J.col0 = 3584; break;
    case 4: J.src = inl(p, 19, l); J.dst = wb + O_WM / 2; J.K = 1024; J.N = 2048; J.lds_ = 2048; J.ldd = 2560; break;
    case 5: J.src = inl(p, 20, l); J.dst = wb + O_WM / 2; J.K = 512; J.N = 2048; J.lds_ = 2048; J.ldd = 2560; J.koff = 1024; break;
    case 6: J.src = inl(p, 20, l); J.dst = wb + O_WM / 2; J.K = 512; J.N = 2048; J.lds_ = 2048; J.ldd = 2560; J.koff = 1536; break;
    case 7: J.src = inl(p, 23, l); J.dst = wb + O_WOUT / 2; J.K = 2048; J.N = 2048; J.lds_ = 2048; J.ldd = 2048; break;
    case 8: J.src = inl(p, 27, l); J.gain = inl(p, 25, l); J.dst = wb + O_WQ / 2; J.K = 2048; J.N = 2048; J.lds_ = 2048; J.ldd = 2048; break;
    case 9: J.src = inl(p, 28, l); J.gain = inl(p, 26, l); J.dst = wb + O_WK / 2; J.K = 2048; J.N = 2048; J.lds_ = 4096; J.ldd = 2048; break;
    case 10: J.src = inl(p, 28, l); J.gain = inl(p, 26, l); J.dst = wb + O_WV / 2; J.K = 2048; J.N = 2048; J.lds_ = 4096; J.ldd = 2048; J.col0 = 2048; break;
    case 11: J.src = inl(p, 29, l); J.dst = wb + O_WO / 2; J.K = 2048; J.N = 2048; J.lds_ = 2048; J.ldd = 2048; break;
    case 12: J.src = inl(p, 32, l); J.gain = inl(p, 31, l); J.dst = wb + O_WGU2 / 2; J.K = 2048; J.N = 11264; J.lds_ = 11264; J.ldd = 2048; J.mode = 1; J.f8 = (l == 1); break;
    case 13: J.src = inl(p, 33, l); J.dst = wb + O_WD2 / 2; J.K = 5632; J.N = 2048; J.lds_ = 2048; J.ldd = 5632; J.f8 = (l == 1); break;
    case 14: J.src = inl(p, 16, l); J.dst = (bf16_t*)(p->ws + O_W4T); J.K = 64; J.N = 4096; J.lds_ = 4096; J.ldd = 256; break;
    default: return false;
  }
  return true;
}

__device__ __forceinline__ void phase_conv(KP p, int l, float* ldsf) {
  const int tid = TIDX();
  {
    int buf = 0;
    const int r = tid >> 5, c4 = (tid & 31) * 4;
    for (int j = 0; j < 15; ++j) {
      CJob J; get_job(p, l, j, J);
      const int nkt = J.K / 64, ntile = nkt * (J.N / 128);
      const float gsc = J.f8 ? F8_SW : 1.0f;
      auto load_tile = [&](f32x4 (&v)[4], int t) {
        const int kt = t % nkt, ntl = t / nkt, k0 = kt * 64, n0 = ntl * 128;
        int scol; if (J.mode == 1) { const int tt = n0 >> 8, h = (n0 >> 7) & 1; scol = h * DFF + tt * 128; } else scol = J.col0 + n0;
        const float* sp = J.src + (size_t)(k0 + r) * J.lds_ + scol + c4;
#pragma unroll
        for (int q = 0; q < 4; ++q) v[q] = __builtin_nontemporal_load((const f32x4*)(sp + (size_t)(16 * q) * J.lds_)); };
      auto process_tile = [&](f32x4 (&v)[4], int t) {
        float* T = ldsf + buf * (64 * 129);
        const int kt = t % nkt, ntl = t / nkt, k0 = kt * 64, n0 = ntl * 128;
#pragma unroll
        for (int q = 0; q < 4; ++q) { const float g = (J.gain ? J.gain[k0 + r + 16 * q] : 1.0f) * gsc; float* d = T + (r + 16 * q) * 129 + c4; d[0] = v[q][0] * g; d[1] = v[q][1] * g; d[2] = v[q][2] * g; d[3] = v[q][3] * g; }
        __syncthreads();
        if (J.f8) {
          const int n = tid >> 2, kc = (tid & 3) * 16;
          float o[16];
#pragma unroll
          for (int i = 0; i < 16; ++i) o[i] = T[(kc + i) * 129 + n];
          u32x4 w; w.x = cvt4_fp8(o[0], o[1], o[2], o[3]); w.y = cvt4_fp8(o[4], o[5], o[6], o[7]); w.z = cvt4_fp8(o[8], o[9], o[10], o[11]); w.w = cvt4_fp8(o[12], o[13], o[14], o[15]);
          *(u32x4*)((unsigned char*)J.dst + (size_t)(n0 + n) * J.ldd + k0 + kc) = w;
        } else {
#pragma unroll
          for (int h = 0; h < 2; ++h) {
            const int id = tid + 512 * h, n = id >> 3, kc = (id & 7) * 8;
            float o[8];
#pragma unroll
            for (int i = 0; i < 8; ++i) o[i] = T[(kc + i) * 129 + n];
            u32x4 w; w.x = cvt_pk_bf16(o[0], o[1]); w.y = cvt_pk_bf16(o[2], o[3]); w.z = cvt_pk_bf16(o[4], o[5]); w.w = cvt_pk_bf16(o[6], o[7]);
            *(u32x4*)(J.dst + (size_t)(n0 + n) * J.ldd + J.koff + k0 + kc) = w;
          }
        }
        buf ^= 1; };
      f32x4 va[4], vb[4];
      int t = BIDX();
      if (t < ntile) load_tile(va, t);
      while (t < ntile) {
        int tn = t + GDIM();
        if (tn < ntile) load_tile(vb, tn);
        process_tile(va, t);
        t = tn; if (t >= ntile) break;
        tn = t + GDIM();
        if (tn < ntile) load_tile(va, tn);
        process_tile(vb, t);
        t = tn;
      }
    }
    __syncthreads();
  }
  {
    const float* win = inl(p, 7, l); const float* gain = inl(p, 6, l); bf16_t* dst = (bf16_t*)p->ws + O_WINT / 2;
    float* tile = ldsf;
    float* ctab = ldsf + 64 * 129;
    if (tid < 128) { const float rv = (float)tid * (1.0f / 128.0f); ctab[tid] = __builtin_amdgcn_cosf(rv); ctab[128 + tid] = __builtin_amdgcn_sinf(rv); }
    const float scale = 0.0013810679f;
    for (int t = BIDX(); t < 256; t += GDIM()) {
      const int kt = t >> 3, g = (t >> 1) & 3, mh = t & 1, k0 = kt * 64;
      __syncthreads();
      for (int e = tid; e < 64 * 32; e += 512) { const int rr = e >> 5, c4 = (e & 31) * 4; const f32x4 v = *(const f32x4*)(win + (size_t)(k0 + rr) * 10240 + 3072 + g * 128 + c4);
        tile[rr * 129 + c4 + 0] = v[0]; tile[rr * 129 + c4 + 1] = v[1]; tile[rr * 129 + c4 + 2] = v[2]; tile[rr * 129 + c4 + 3] = v[3]; }
      __syncthreads();
      const int kk = tid & 63, mg = tid >> 6;
      float ac[8], as[8];
#pragma unroll
      for (int i = 0; i < 8; ++i) { ac[i] = 0.f; as[i] = 0.f; }
      for (int c = 0; c < 128; ++c) {
        const float x = tile[kk * 129 + c];
#pragma unroll
        for (int i = 0; i < 8; ++i) { const int m = mh * 64 + mg * 8 + i; const int ix = (m * c) & 127; ac[i] += x * ctab[ix]; as[i] += x * ctab[128 + ix]; }
      }
      const float gs = gain[k0 + kk] * scale;
#pragma unroll
      for (int i = 0; i < 8; ++i) { const int m = mh * 64 + mg * 8 + i;
        dst[(size_t)(3072 + g * 128 + m) * 2048 + k0 + kk] = f2bf(ac[i] * gs);
        dst[(size_t)(3072 + 512 + g * 128 + m) * 2048 + k0 + kk] = f2bf(as[i] * gs); }
    }
    __syncthreads();
  }
  {
    const float* wp = inl(p, 21, l); const float* ps = inl(p, 22, l); bf16_t* dst = (bf16_t*)p->ws + O_WM / 2;
    for (size_t e = (size_t)BIDX() * 512 + tid; e < (size_t)2048 * 512; e += (size_t)GDIM() * 512) {
      const int d = (int)(e >> 9), kk = (int)(e & 511), g = kk >> 7, c = kk & 127;
      float v = 0.f; if (g == (d >> 9)) v = wp[(size_t)(g * 128 + c) * 512 + (d & 511)] * ps[d];
      dst[(size_t)d * 2560 + 2048 + kk] = f2bf(v);
    }
    { bf16_t* w4t = (bf16_t*)(p->ws + O_W4T); bf16_t* hb = (bf16_t*)(p->ws + O_HIDB);
      for (size_t e = (size_t)BIDX() * 512 + tid; e < (size_t)4096 * 24; e += (size_t)GDIM() * 512) { const int n = (int)(e / 24), c8 = 64 + (int)(e % 24) * 8; const u32x4 z = {0u, 0u, 0u, 0u}; *(u32x4*)(w4t + (size_t)n * 256 + c8) = z; *(u32x4*)(hb + (size_t)n * 256 + c8) = z; } }
  }
}

__device__ __forceinline__ void phase_dftm(KP p, float* ldsf) {
  const int tid = TIDX();
  __syncthreads();
  for (int i = tid; i < 4096; i += 512) ldsf[i] = __builtin_amdgcn_cosf((float)i * (1.0f / 4096.0f));
  __syncthreads();
  bf16_t* D = (bf16_t*)(p->ws + O_DFTM);
  for (size_t e = (size_t)BIDX() * 512 + tid; e < (size_t)4096 * 1024; e += (size_t)GDIM() * 512) {
    const int k = (int)(e >> 10), j0 = (int)(e & 1023) * 8;
    float o[8];
#pragma unroll
    for (int i = 0; i < 8; ++i) { const int j = j0 + i;
      if (j < 4096) o[i] = ldsf[(k * j) & 4095]; else o[i] = -ldsf[((k * (j - 4096)) - 1024) & 4095]; }
    u32x4 w; w.x = cvt_pk_bf16(o[0], o[1]); w.y = cvt_pk_bf16(o[2], o[3]); w.z = cvt_pk_bf16(o[4], o[5]); w.w = cvt_pk_bf16(o[6], o[7]);
    *(u32x4*)(D + (size_t)k * 8192 + j0) = w;
  }
  __syncthreads();
}

__device__ __forceinline__ void phase_prep(KP p) {
  const int lane = TIDX() & 63, gw = (BIDX() * 512 + TIDX()) >> 6, nw = (GDIM() * 512) >> 6;
  for (int row = gw; row < NTOK + MEMROWS; row += nw) {
    const bool isx = row < NTOK; const int r = isx ? row : row - NTOK;
    const float* src = (isx ? p->in[0] : p->in[1]) + (size_t)r * DM;
    f32x4 v[8]; float ss = 0.f;
#pragma unroll
    for (int i = 0; i < 8; ++i) { v[i] = __builtin_nontemporal_load((const f32x4*)(src + lane * 4 + i * 256)); ss += (v[i][0] * v[i][0] + v[i][1] * v[i][1]) + (v[i][2] * v[i][2] + v[i][3] * v[i][3]); }
    ss = wave_sum(ss);
    const float rr = rsqrtf(ss * (1.0f / DM) + RMS_EPS);
    { bf16_t* dst = (bf16_t*)(p->ws + (isx ? O_XB : O_MB)) + (size_t)r * DM;
#pragma unroll
      for (int i = 0; i < 8; ++i) { u32x2 w; w.x = cvt_pk_bf16(v[i][0], v[i][1]); w.y = cvt_pk_bf16(v[i][2], v[i][3]); *(u32x2*)(dst + lane * 4 + i * 256) = w; }
    }
    if (lane == 0) ((float*)(p->ws + (isx ? O_RSTD : O_RSTDM)))[r] = rr;
  }
}

__device__ __forceinline__ void phase_resid(KP p, const float* xsrc, const float* gpost, float wgt, bool out8) {
  const int lane = TIDX() & 63, gw = (BIDX() * 512 + TIDX()) >> 6, nw = (GDIM() * 512) >> 6;
  const bf16_t* Y = (const bf16_t*)(p->ws + A_Y); const float* part = (const float*)(p->ws + O_PART);
  bf16_t* xb = (bf16_t*)(p->ws + O_XB); float* rstd = (float*)(p->ws + O_RSTD);
  for (int row0 = gw; row0 < NTOK; row0 += 2 * nw) {
    const int rowA = row0, rowB = row0 + nw;
    float psA = lane < 32 ? part[(size_t)rowA * 32 + lane] : 0.f, psB = lane < 32 ? part[(size_t)rowB * 32 + lane] : 0.f;
    u32x2 ya[8], yb[8]; f32x4 xa[8], xq[8];
#pragma unroll
    for (int i = 0; i < 8; ++i) { const int c = lane * 4 + i * 256; const size_t oa = (size_t)rowA * DM + c, ob = (size_t)rowB * DM + c;
      ya[i] = __builtin_nontemporal_load((const u32x2*)(Y + oa)); yb[i] = __builtin_nontemporal_load((const u32x2*)(Y + ob)); xa[i] = __builtin_nontemporal_load((const f32x4*)(xsrc + oa)); xq[i] = __builtin_nontemporal_load((const f32x4*)(xsrc + ob)); }
    psA = wave_sum(psA); psB = wave_sum(psB);
    const float rA = rsqrtf(psA * (1.0f / DM) + RMS_EPS) * wgt, rB = rsqrtf(psB * (1.0f / DM) + RMS_EPS) * wgt;
    float ssA = 0.f, ssB = 0.f;
#pragma unroll
    for (int i = 0; i < 8; ++i) { const int c = lane * 4 + i * 256; const f32x4 g = *(const f32x4*)(gpost + c);
      f32x4 y; y[0] = bf2f(ya[i].x & 0xffffu); y[1] = bf2f(ya[i].x >> 16); y[2] = bf2f(ya[i].y & 0xffffu); y[3] = bf2f(ya[i].y >> 16);
      xa[i] = xa[i] + y * g * rA; ssA += (xa[i][0] * xa[i][0] + xa[i][1] * xa[i][1]) + (xa[i][2] * xa[i][2] + xa[i][3] * xa[i][3]);
      y[0] = bf2f(yb[i].x & 0xffffu); y[1] = bf2f(yb[i].x >> 16); y[2] = bf2f(yb[i].y & 0xffffu); y[3] = bf2f(yb[i].y >> 16);
      xq[i] = xq[i] + y * g * rB; ssB += (xq[i][0] * xq[i][0] + xq[i][1] * xq[i][1]) + (xq[i][2] * xq[i][2] + xq[i][3] * xq[i][3]);
      *(f32x4*)(p->out + (size_t)rowA * DM + c) = xa[i]; *(f32x4*)(p->out + (size_t)rowB * DM + c) = xq[i]; }
    ssA = wave_sum(ssA); ssB = wave_sum(ssB);
    const float rrA = rsqrtf(ssA * (1.0f / DM) + RMS_EPS), rrB = rsqrtf(ssB * (1.0f / DM) + RMS_EPS);
    if (out8) {
      unsigned* dA = (unsigned*)(p->ws + O_XB8 + (size_t)rowA * DM); unsigned* dB = (unsigned*)(p->ws + O_XB8 + (size_t)rowB * DM); const float qa = rrA * F8_SA, qb = rrB * F8_SA;
#pragma unroll
      for (int i = 0; i < 8; ++i) { dA[lane + i * 64] = cvt4_fp8(xa[i][0] * qa, xa[i][1] * qa, xa[i][2] * qa, xa[i][3] * qa); dB[lane + i * 64] = cvt4_fp8(xq[i][0] * qb, xq[i][1] * qb, xq[i][2] * qb, xq[i][3] * qb); }
    } else {
#pragma unroll
      for (int i = 0; i < 8; ++i) { u32x2 w; w.x = cvt_pk_bf16(xa[i][0], xa[i][1]); w.y = cvt_pk_bf16(xa[i][2], xa[i][3]); *(u32x2*)(xb + (size_t)rowA * DM + lane * 4 + i * 256) = w;
        w.x = cvt_pk_bf16(xq[i][0], xq[i][1]); w.y = cvt_pk_bf16(xq[i][2], xq[i][3]); *(u32x2*)(xb + (size_t)rowB * DM + lane * 4 + i * 256) = w; }
    }
    if (lane == 0) { rstd[rowA] = rrA; rstd[rowB] = rrB; }
  }
}

__device__ __forceinline__ void phase_hid(KP p, int l) {
  const int lane = TIDX() & 63, gw = (BIDX() * 512 + TIDX()) >> 6, nw = (GDIM() * 512) >> 6;
  const float* w1 = inl(p, 10, l); const float* b1 = inl(p, 11, l); const float* w2 = inl(p, 12, l); const float* b2 = inl(p, 13, l);
  const float* w3 = inl(p, 14, l); const float* b3 = inl(p, 15, l); const float* fq = inl(p, 17, l);
  const float f = fq[lane];
  for (int pos = gw; pos < SEQ; pos += nw) {
    float z = 0.f;
    if (lane == 0) z = (float)pos / (float)(SEQ - 1);
    else if (lane < 33) { const int j = (lane - 1) & 15; const float band = 1e-4f + (float)j * ((15.0f - 1e-4f) / 15.0f);
      const float rev = (float)pos * band * (1.0f / (float)SEQ); z = lane < 17 ? __builtin_amdgcn_cosf(rev) : -__builtin_amdgcn_sinf(rev); }
    float a = b1[lane];
    for (int i = 0; i < 33; ++i) a += __int_as_float(__builtin_amdgcn_readlane(__float_as_int(z), i)) * w1[i * 64 + lane];
    float h = __builtin_amdgcn_sinf(f * a * 0.15915494309189535f);
    a = b2[lane];
    for (int i = 0; i < 64; ++i) a += __int_as_float(__builtin_amdgcn_readlane(__float_as_int(h), i)) * w2[i * 64 + lane];
    h = __builtin_amdgcn_sinf(f * a * 0.15915494309189535f);
    a = b3[lane];
    for (int i = 0; i < 64; ++i) a += __int_as_float(__builtin_amdgcn_readlane(__float_as_int(h), i)) * w3[i * 64 + lane];
    h = __builtin_amdgcn_sinf(f * a * 0.15915494309189535f);
    ((bf16_t*)(p->ws + O_HIDB))[(size_t)pos * 256 + lane] = f2bf(h);
  }
}

__device__ __forceinline__ void phase_filt(KP p, int l, float* ldsf) {
  const int tid = TIDX();
  const float* hid = (const float*)(p->ws + O_HID); const float* fw4 = inl(p, 16, l);
  float* TS = (float*)(p->ws + A_MB16);
  const float min_decay = -3.0701134573f, max_decay = -15.3505672866f;
  for (int tile = BIDX(); tile < 128 * 8; tile += GDIM()) {
    const int pt = tile >> 3, ct = tile & 7, pos0 = pt * 32, col = ct * 512 + tid, q = col >> 10, ch = col & 1023, o = q >> 1, dir = q & 1;
    __syncthreads();
    for (int e = tid; e < 32 * 64; e += 512) ldsf[e] = hid[(size_t)pos0 * 64 + e];
    __syncthreads();
    float acc[32];
#pragma unroll
    for (int i = 0; i < 32; ++i) acc[i] = 0.f;
    for (int i = 0; i < 64; i += 4) {
      const float wa = fw4[(size_t)i * 4096 + col], wb = fw4[(size_t)(i + 1) * 4096 + col], wc = fw4[(size_t)(i + 2) * 4096 + col], wd = fw4[(size_t)(i + 3) * 4096 + col];
#pragma unroll
      for (int pp = 0; pp < 32; ++pp) { const f32x4 h = *(const f32x4*)(ldsf + pp * 64 + i); acc[pp] += h[0] * wa + h[1] * wb + h[2] * wc + h[3] * wd; }
    }
    const float delta = fabsf(min_decay + (float)ch * ((max_decay - min_decay) / 1023.0f));
    float* stage = ldsf + 2048;
#pragma unroll
    for (int pp = 0; pp < 32; ++pp) {
      const int pos = pos0 + pp;
      stage[tid * 33 + pp] = acc[pp] * __expf(-((float)pos / (float)(SEQ - 1)) * delta) * (1.0f / 8192.0f);
    }
    __syncthreads();
    const int jj = tid & 31;
#pragma unroll 4
    for (int it = 0; it < 32; ++it) {
      const int row = it * 16 + (tid >> 5), rcol = ct * 512 + row, rch = rcol & 1023;
      float* dst = TS + (size_t)(o * 1024 + rch) * 8192; const float val = stage[row * 33 + jj]; const int pos = pos0 + jj;
      if (dir == 0) dst[pos] = val; else if (pos == 0) dst[4096] = 0.f; else dst[8192 - pos] = val;
    }
  }
  __syncthreads();
}

__device__ __forceinline__ f32x2 cmul(f32x2 a, f32x2 b) { return (f32x2){a.x * b.x - a.y * b.y, a.x * b.y + a.y * b.x}; }
template <bool INV> __device__ __forceinline__ void dft4(f32x2& a, f32x2& b, f32x2& c, f32x2& d) {
  const f32x2 s0 = a + c, s1 = a - c, s2 = b + d, s3 = b - d;
  const f32x2 js3 = INV ? (f32x2){-s3.y, s3.x} : (f32x2){s3.y, -s3.x};
  a = s0 + s2; c = s0 - s2; b = s1 + js3; d = s1 - js3;
}
#define XI(k) ((((k) & 3) * 4) + ((k) >> 2))
template <bool INV> __device__ __forceinline__ void dft16(f32x2 (&v)[16]) {
#pragma unroll
  for (int b = 0; b < 4; ++b) dft4<INV>(v[b], v[4 + b], v[8 + b], v[12 + b]);
  const float C1 = 0.92387953251f, S1 = 0.38268343236f, R2 = 0.70710678118f;
  const f32x2 W1 = {C1, INV ? S1 : -S1}, W2 = {R2, INV ? R2 : -R2}, W3 = {S1, INV ? C1 : -C1}, W4 = {0.f, INV ? 1.f : -1.f}, W6 = {-R2, INV ? R2 : -R2}, W9 = {-C1, INV ? -S1 : S1};
  v[4 * 1 + 1] = cmul(v[4 * 1 + 1], W1); v[4 * 1 + 2] = cmul(v[4 * 1 + 2], W2); v[4 * 1 + 3] = cmul(v[4 * 1 + 3], W3);
  v[4 * 2 + 1] = cmul(v[4 * 2 + 1], W2); v[4 * 2 + 2] = cmul(v[4 * 2 + 2], W4); v[4 * 2 + 3] = cmul(v[4 * 2 + 3], W6);
  v[4 * 3 + 1] = cmul(v[4 * 3 + 1], W3); v[4 * 3 + 2] = cmul(v[4 * 3 + 2], W6); v[4 * 3 + 3] = cmul(v[4 * 3 + 3], W9);
#pragma unroll
  for (int c = 0; c < 4; ++c) dft4<INV>(v[4 * c + 0], v[4 * c + 1], v[4 * c + 2], v[4 * c + 3]);
}
__device__ __forceinline__ void twiddle16(f32x2 (&v)[16], f32x2 w) {
  asm volatile("" : "+v"(w.x), "+v"(w.y));
  const f32x2 w2 = cmul(w, w), w3 = cmul(w2, w), w4 = cmul(w2, w2), w5 = cmul(w4, w), w6 = cmul(w4, w2), w7 = cmul(w4, w3), w8 = cmul(w4, w4);
  v[XI(1)] = cmul(v[XI(1)], w); v[XI(2)] = cmul(v[XI(2)], w2); v[XI(3)] = cmul(v[XI(3)], w3); v[XI(4)] = cmul(v[XI(4)], w4);
  v[XI(5)] = cmul(v[XI(5)], w5); v[XI(6)] = cmul(v[XI(6)], w6); v[XI(7)] = cmul(v[XI(7)], w7); v[XI(8)] = cmul(v[XI(8)], w8);
  v[XI(9)] = cmul(v[XI(9)], cmul(w8, w)); v[XI(10)] = cmul(v[XI(10)], cmul(w8, w2)); v[XI(11)] = cmul(v[XI(11)], cmul(w8, w3)); v[XI(12)] = cmul(v[XI(12)], cmul(w8, w4));
  v[XI(13)] = cmul(v[XI(13)], cmul(w8, w5)); v[XI(14)] = cmul(v[XI(14)], cmul(w8, w6)); v[XI(15)] = cmul(v[XI(15)], cmul(w8, w7));
}
__device__ __forceinline__ void twiddle16n(f32x2 (&v)[16], f32x2 w) {
  asm volatile("" : "+v"(w.x), "+v"(w.y));
  const f32x2 w2 = cmul(w, w), w3 = cmul(w2, w), w4 = cmul(w2, w2), w5 = cmul(w4, w), w6 = cmul(w4, w2), w7 = cmul(w4, w3), w8 = cmul(w4, w4);
  v[1] = cmul(v[1], w); v[2] = cmul(v[2], w2); v[3] = cmul(v[3], w3); v[4] = cmul(v[4], w4); v[5] = cmul(v[5], w5); v[6] = cmul(v[6], w6); v[7] = cmul(v[7], w7); v[8] = cmul(v[8], w8);
  v[9] = cmul(v[9], cmul(w8, w)); v[10] = cmul(v[10], cmul(w8, w2)); v[11] = cmul(v[11], cmul(w8, w3)); v[12] = cmul(v[12], cmul(w8, w4));
  v[13] = cmul(v[13], cmul(w8, w5)); v[14] = cmul(v[14], cmul(w8, w6)); v[15] = cmul(v[15], cmul(w8, w7));
}
__device__ __forceinline__ int PADI(int i) { return i + (i >> 5); }
__device__ __forceinline__ float dpp_xor1(float x) { return __int_as_float(__builtin_amdgcn_mov_dpp(__float_as_int(x), 0xB1, 0xF, 0xF, true)); }

struct FftCtx { f32x2 w1; int P1, P2, P3, n3, t31;
  __device__ __forceinline__ f32x2 w2f() const { int q = t31; asm volatile("" : "+v"(q)); const float r = -(float)q * (1.0f / 512.0f); return (f32x2){__builtin_amdgcn_cosf(r), __builtin_amdgcn_sinf(r)}; }
  __device__ __forceinline__ f32x2 w3f() const { int q = n3; asm volatile("" : "+v"(q)); const float r = -(float)q * (1.0f / 32.0f); return (f32x2){__builtin_amdgcn_cosf(r), __builtin_amdgcn_sinf(r)}; } };

__device__ __forceinline__ void fft_fwd2(f32x2 (&x)[16], f32x2 (&y)[16], const FftCtx& c, f32x2* bufA, f32x2* bufB) {
  dft16<false>(x); twiddle16(x, c.w1); __builtin_amdgcn_sched_barrier(0); dft16<false>(y); twiddle16(y, c.w1); __builtin_amdgcn_sched_barrier(0);
#pragma unroll
  for (int k = 0; k < 16; ++k) { bufA[c.P1 + k * 528] = x[XI(k)]; bufB[c.P1 + k * 528] = y[XI(k)]; }
  __syncthreads();
#pragma unroll
  for (int n = 0; n < 16; ++n) { x[n] = bufA[c.P2 + n * 33]; y[n] = bufB[c.P2 + n * 33]; }
  dft16<false>(x); twiddle16(x, c.w2f()); __builtin_amdgcn_sched_barrier(0); dft16<false>(y); twiddle16(y, c.w2f()); __builtin_amdgcn_sched_barrier(0);
#pragma unroll
  for (int k = 0; k < 16; ++k) { bufA[c.P2 + k * 33] = x[XI(k)]; bufB[c.P2 + k * 33] = y[XI(k)]; }
  __syncthreads();
#pragma unroll
  for (int n = 0; n < 16; ++n) { x[n] = bufA[c.P3 + n * 2]; y[n] = bufB[c.P3 + n * 2]; }
  dft16<false>(x); twiddle16(x, c.w3f()); __builtin_amdgcn_sched_barrier(0); dft16<false>(y); twiddle16(y, c.w3f()); __builtin_amdgcn_sched_barrier(0);
#pragma unroll
  for (int i = 0; i < 16; ++i) { const f32x2 o = {dpp_xor1(x[i].x), dpp_xor1(x[i].y)}; x[i] = c.n3 ? (o - x[i]) : (x[i] + o);
                                 const f32x2 q = {dpp_xor1(y[i].x), dpp_xor1(y[i].y)}; y[i] = c.n3 ? (q - y[i]) : (y[i] + q); }
}
__device__ __forceinline__ void fft_inv2(f32x2 (&x)[16], f32x2 (&y)[16], const FftCtx& c, f32x2* bufA, f32x2* bufB) {
  f32x2 u[16], w[16];
#pragma unroll
  for (int k = 0; k < 16; ++k) { const f32x2 own = x[XI(k)]; const f32x2 o = {dpp_xor1(own.x), dpp_xor1(own.y)}; u[k] = c.n3 ? (o - own) : (own + o);
                                 const f32x2 owy = y[XI(k)]; const f32x2 q = {dpp_xor1(owy.x), dpp_xor1(owy.y)}; w[k] = c.n3 ? (q - owy) : (owy + q); }
  { const f32x2 q3 = c.w3f(); twiddle16n(u, (f32x2){q3.x, -q3.y}); } dft16<true>(u); __builtin_amdgcn_sched_barrier(0); { const f32x2 q3 = c.w3f(); twiddle16n(w, (f32x2){q3.x, -q3.y}); } dft16<true>(w); __builtin_amdgcn_sched_barrier(0);
#pragma unroll
  for (int n = 0; n < 16; ++n) { bufA[c.P3 + n * 2] = u[XI(n)]; bufB[c.P3 + n * 2] = w[XI(n)]; }
  __syncthreads();
#pragma unroll
  for (int k = 0; k < 16; ++k) { u[k] = bufA[c.P2 + k * 33]; w[k] = bufB[c.P2 + k * 33]; }
  { const f32x2 q2 = c.w2f(); twiddle16n(u, (f32x2){q2.x, -q2.y}); } dft16<true>(u); __builtin_amdgcn_sched_barrier(0); { const f32x2 q2 = c.w2f(); twiddle16n(w, (f32x2){q2.x, -q2.y}); } dft16<true>(w); __builtin_amdgcn_sched_barrier(0);
#pragma unroll
  for (int n = 0; n < 16; ++n) { bufA[c.P2 + n * 33] = u[XI(n)]; bufB[c.P2 + n * 33] = w[XI(n)]; }
  __syncthreads();
#pragma unroll
  for (int k = 0; k < 16; ++k) { u[k] = bufA[c.P1 + k * 528]; w[k] = bufB[c.P1 + k * 528]; }
  twiddle16n(u, (f32x2){c.w1.x, -c.w1.y}); dft16<true>(u); __builtin_amdgcn_sched_barrier(0); twiddle16n(w, (f32x2){c.w1.x, -c.w1.y}); dft16<true>(w); __builtin_amdgcn_sched_barrier(0);
#pragma unroll
  for (int i = 0; i < 16; ++i) { x[i] = u[i]; y[i] = w[i]; }
}

__device__ __forceinline__ float sconv(const bf16_t* col, int l, float w0, float w1, float w2, float cb) {
  const float um = bf2f(col[l - 1]), u0 = bf2f(col[l]), up = bf2f(col[l + 1]);
  return cb + w0 * (l > 0 ? um : 0.f) + w1 * u0 + w2 * (l < SEQ - 1 ? up : 0.f);
}

__device__ __forceinline__ void phase_hyena(KP p, int l, unsigned char* ldsraw) {
  f32x2* bufA = (f32x2*)ldsraw; f32x2* bufB = bufA + 8448;
  const int t = TIDX();
  FftCtx c; c.P1 = t + (t >> 5); c.P2 = (t >> 5) * 528 + (t & 31); c.P3 = (t >> 1) * 33 + (t & 1); c.n3 = t & 1; c.t31 = t & 31;
  { const float r1 = -(float)t * (1.0f / 8192.0f); c.w1 = (f32x2){__builtin_amdgcn_cosf(r1), __builtin_amdgcn_sinf(r1)}; }
  const float* TS = (const float*)(p->ws + A_MB16);
  const float* cw = inl(p, 8, l); const float* cbp = inl(p, 9, l); const float* dsk = inl(p, 18, l);
  const bf16_t* HT = (const bf16_t*)(p->ws + A_HTFT);
  bf16_t* Z2T = (bf16_t*)(p->ws + A_Z2T);
  f32x2* Hs = (f32x2*)(p->ws + A_HST + (size_t)BIDX() * 131072);
  for (int ch = BIDX(); ch < 1024; ch += GDIM()) {
    const float* tsa = TS + (size_t)ch * 8192; const float* tsb = TS + (size_t)(1024 + ch) * 8192;
    f32x2 x[16], y[16];
    { int tt = t; asm volatile("" : "+v"(tt));
#pragma unroll
      for (int i = 0; i < 16; ++i) { x[i] = (f32x2){__builtin_nontemporal_load(tsa + i * 512 + tt), 0.f}; y[i] = (f32x2){__builtin_nontemporal_load(tsb + i * 512 + tt), 0.f}; } }
    fft_fwd2(x, y, c, bufA, bufB);
    { int tt = t; asm volatile("" : "+v"(tt));
#pragma unroll
      for (int k = 0; k < 16; ++k) { Hs[k * 512 + tt] = x[XI(k)]; Hs[8192 + k * 512 + tt] = y[XI(k)]; } }
    float w0[3], w1[3], w2[3], cb[3];
#pragma unroll
    for (int q = 0; q < 3; ++q) { const int col = q * 1024 + ch; w0[q] = cw[col]; w1[q] = cw[3072 + col]; w2[q] = cw[6144 + col]; cb[q] = cbp[col]; }
    const float d1 = dsk[ch], d2 = dsk[1024 + ch];
    const bf16_t* colv = HT + (size_t)ch * NTOK; const bf16_t* colg = HT + (size_t)(1024 + ch) * NTOK; const bf16_t* colh = HT + (size_t)(2048 + ch) * NTOK;
    unsigned zp[8], zq[8];
    { int t1 = t; asm volatile("" : "+v"(t1));
#pragma unroll
      for (int n1 = 0; n1 < 8; ++n1) { const int pos = n1 * 512 + t1;
        zp[n1] = cvt_pk_bf16(sconv(colv, pos, w0[0], w1[0], w2[0], cb[0]), sconv(colv + SEQ, pos, w0[0], w1[0], w2[0], cb[0]));
        zq[n1] = cvt_pk_bf16(sconv(colv + 2 * SEQ, pos, w0[0], w1[0], w2[0], cb[0]), sconv(colv + 3 * SEQ, pos, w0[0], w1[0], w2[0], cb[0])); } }
#pragma unroll
    for (int o = 0; o < 2; ++o) {
      const float dd = o ? d2 : d1; const bf16_t* gc = o ? colh : colg; const int q = 1 + o;
#pragma unroll
      for (int i = 0; i < 8; ++i) { x[i] = (f32x2){bf2f(zp[i] & 0xffffu), bf2f(zp[i] >> 16)}; x[8 + i] = (f32x2){0.f, 0.f}; y[i] = (f32x2){bf2f(zq[i] & 0xffffu), bf2f(zq[i] >> 16)}; y[8 + i] = (f32x2){0.f, 0.f}; }
      fft_fwd2(x, y, c, bufA, bufB);
      { int tt = t; asm volatile("" : "+v"(tt));
#pragma unroll
        for (int k = 0; k < 16; ++k) { const f32x2 hh = Hs[o * 8192 + k * 512 + tt]; x[XI(k)] = cmul(x[XI(k)], hh); y[XI(k)] = cmul(y[XI(k)], hh); } }
      fft_inv2(x, y, c, bufA, bufB);
      { int t2 = t; asm volatile("" : "+v"(t2));
#pragma unroll
        for (int n1 = 0; n1 < 8; ++n1) { const int pos = n1 * 512 + t2; const f32x2 a = x[XI(n1)], b = y[XI(n1)];
          const float r0 = sconv(gc, pos, w0[q], w1[q], w2[q], cb[q]) * (a.x + dd * bf2f(zp[n1] & 0xffffu)), r1 = sconv(gc + SEQ, pos, w0[q], w1[q], w2[q], cb[q]) * (a.y + dd * bf2f(zp[n1] >> 16));
          const float r2 = sconv(gc + 2 * SEQ, pos, w0[q], w1[q], w2[q], cb[q]) * (b.x + dd * bf2f(zq[n1] & 0xffffu)), r3 = sconv(gc + 3 * SEQ, pos, w0[q], w1[q], w2[q], cb[q]) * (b.y + dd * bf2f(zq[n1] >> 16));
          zp[n1] = cvt_pk_bf16(r0, r1); zq[n1] = cvt_pk_bf16(r2, r3); } }
    }
    { bf16_t* o0 = Z2T + (size_t)ch * NTOK; int t3 = t; asm volatile("" : "+v"(t3));
#pragma unroll
      for (int n1 = 0; n1 < 8; ++n1) { o0[n1 * 512 + t3] = (bf16_t)(zp[n1] & 0xffffu); o0[SEQ + n1 * 512 + t3] = (bf16_t)(zp[n1] >> 16); o0[2 * SEQ + n1 * 512 + t3] = (bf16_t)(zq[n1] & 0xffffu); o0[3 * SEQ + n1 * 512 + t3] = (bf16_t)(zq[n1] >> 16); } }
  }
  __syncthreads();
}

__device__ __forceinline__ void phase_poolt(KP p, unsigned char* ldsraw) {
  const int tid = TIDX();
  bf16_t* tl = (bf16_t*)ldsraw;
  const bf16_t* Z2T = (const bf16_t*)(p->ws + A_Z2T); bf16_t* ZC = (bf16_t*)(p->ws + A_ZCAT); const bf16_t* PN = (const bf16_t*)(p->ws + A_PN);
  for (int tile = BIDX(); tile < 16 * 256; tile += GDIM()) {
    const int c0 = (tile & 15) * 64, t0 = (tile >> 4) * 64;
    const int i = tid >> 3, jj = (tid & 7) * 8;
    __syncthreads();
    { const u32x4 w = __builtin_nontemporal_load((const u32x4*)(Z2T + (size_t)(c0 + i) * NTOK + t0 + jj));
      *(u32x4*)(tl + i * 72 + jj) = w; }
    __syncthreads();
    { unsigned e[8];
#pragma unroll
      for (int q = 0; q < 8; ++q) e[q] = tl[(jj + q) * 72 + i];
      u32x4 w; w.x = e[0] | (e[1] << 16); w.y = e[2] | (e[3] << 16); w.z = e[4] | (e[5] << 16); w.w = e[6] | (e[7] << 16);
      *(u32x4*)(ZC + (size_t)(t0 + i) * 2560 + c0 + jj) = w; }
  }
  for (size_t e = (size_t)BIDX() * 512 + tid; e < (size_t)NTOK * 64; e += (size_t)GDIM() * 512) {
    const int tok = (int)(e >> 6), c8 = (int)(e & 63) * 8, g = c8 >> 7, w = 2 << g, before = w >> 1, after = w - 1 - before;
    const int b = tok >> 12, l = tok & 4095;
    int lo = l - before; if (lo < 0) lo = 0; int hi = l + after; if (hi > SEQ - 1) hi = SEQ - 1;
    float s[8];
#pragma unroll
    for (int q = 0; q < 8; ++q) s[q] = 0.f;
    u32x4 wv[16];
#pragma unroll
    for (int j = 0; j < 16; ++j) { int r = l - before + j; r = r < 0 ? 0 : (r > SEQ - 1 ? SEQ - 1 : r); wv[j] = *(const u32x4*)(PN + (size_t)(b * SEQ + r) * 6656 + c8); }
#pragma unroll
    for (int j = 0; j < 16; ++j) { const int r = l - before + j; const float m = (j < w && r >= 0 && r <= SEQ - 1) ? 1.0f : 0.0f;
      s[0] += m * bf2f(wv[j].x & 0xffff); s[1] += m * bf2f(wv[j].x >> 16); s[2] += m * bf2f(wv[j].y & 0xffff); s[3] += m * bf2f(wv[j].y >> 16);
      s[4] += m * bf2f(wv[j].z & 0xffff); s[5] += m * bf2f(wv[j].z >> 16); s[6] += m * bf2f(wv[j].w & 0xffff); s[7] += m * bf2f(wv[j].w >> 16); }
    const u32x4 sv = *(const u32x4*)(PN + (size_t)tok * 6656 + c8);
    const float inv = 1.0f / (float)(hi - lo + 1);
    float o[8];
    o[0] = s[0] * inv - bf2f(sv.x & 0xffff); o[1] = s[1] * inv - bf2f(sv.x >> 16); o[2] = s[2] * inv - bf2f(sv.y & 0xffff); o[3] = s[3] * inv - bf2f(sv.y >> 16);
    o[4] = s[4] * inv - bf2f(sv.z & 0xffff); o[5] = s[5] * inv - bf2f(sv.z >> 16); o[6] = s[6] * inv - bf2f(sv.w & 0xffff); o[7] = s[7] * inv - bf2f(sv.w >> 16);
    u32x4 w4; w4.x = cvt_pk_bf16(o[0], o[1]); w4.y = cvt_pk_bf16(o[2], o[3]); w4.z = cvt_pk_bf16(o[4], o[5]); w4.w = cvt_pk_bf16(o[6], o[7]);
    *(u32x4*)(ZC + (size_t)tok * 2560 + 2048 + c8) = w4;
  }
  __syncthreads();
}

#define XB_TMO      128
#define XB_XCNT(j)  (256  + 64 * (j))
#define XB_XSUB(j)  (1280 + 64 * (j))
#define XB_XGEN(j)  (2304 + 64 * (j))
#define XB_TOP      3328
#define XB_TOPGEN   3392
#define XCD_BAR_WORDS 3456
#define XB_SPIN_CAP (1u << 18)

__device__ __forceinline__ unsigned xb_ld(unsigned* p)              { return __hip_atomic_load(p, __ATOMIC_RELAXED, __HIP_MEMORY_SCOPE_AGENT); }
__device__ __forceinline__ unsigned xb_add(unsigned* p, unsigned v) { return __hip_atomic_fetch_add(p, v, __ATOMIC_RELAXED, __HIP_MEMORY_SCOPE_AGENT); }
__device__ __forceinline__ unsigned xb_xcc_id() { return (unsigned)__builtin_amdgcn_s_getreg((3 << 11) | 20) & 0xFu; }
#define XB_SPIN(cond, bar) do { unsigned _sp = 0; while (cond) { __builtin_amdgcn_s_sleep(1); \
    if ((++_sp & 255u) == 0u) { if (xb_ld(&(bar)[XB_TMO])) break; if (_sp > XB_SPIN_CAP) { atomicAdd(&(bar)[XB_TMO], 1u); break; } } } } while (0)

struct XcdBarrier {
    unsigned* bar; unsigned x;
    volatile LAS unsigned* st;
};

__device__ __forceinline__ XcdBarrier xcd_barrier_post(unsigned* bar, volatile LAS unsigned* st) {
    XcdBarrier b; b.bar = bar; b.x = xb_xcc_id(); b.st = st;
    if (TIDX() == 0) (void)xb_add(&bar[XB_XCNT(b.x)], 1u);
    return b;
}
__device__ __forceinline__ void xcd_barrier_complete(unsigned* bar, unsigned x, unsigned& nloc, unsigned& nx) {
    const unsigned G = (unsigned)GDIM();
    unsigned sum, cnt, mine, sp = 0u;
    for (;;) {
        sum = 0u; cnt = 0u; mine = 0u;
#pragma unroll
        for (unsigned j = 0; j < 16; ++j) { const unsigned c = xb_ld(&bar[XB_XCNT(j)]); sum += c; cnt += (c > 0u) ? 1u : 0u; mine = (j == x) ? c : mine; }
        if (sum == G) break;
        __builtin_amdgcn_s_sleep(1);
        if ((++sp & 255u) == 0u) { if (xb_ld(&bar[XB_TMO])) break; if (sp > XB_SPIN_CAP) { atomicAdd(&bar[XB_TMO], 1u); break; } }
    }
    nloc = mine > 0u ? mine : 1u; nx = cnt > 0u ? cnt : 1u;
}

__device__ __forceinline__ void xcd_barrier(const XcdBarrier& b) {
    asm volatile("s_waitcnt vmcnt(0)" ::: "memory");
    __syncthreads();
    if (TIDX() == 0) {
        unsigned* bar = b.bar; asm volatile("" : "+s"(bar));
        __builtin_amdgcn_s_waitcnt(0);
        unsigned nloc = b.st[0], nx = b.st[1];
        if (nloc == 0u) { xcd_barrier_complete(bar, b.x, nloc, nx); b.st[0] = nloc; b.st[1] = nx; }
        const unsigned old = xb_add(&bar[XB_XSUB(b.x)], 1u);
        const unsigned gen = old / nloc;
        if (old + 1u == (gen + 1u) * nloc) {
            __builtin_amdgcn_fence(__ATOMIC_RELEASE, "agent");
            asm volatile("s_waitcnt vmcnt(0)" ::: "memory");
            const unsigned og = xb_add(&bar[XB_TOP], 1u);
            const unsigned tg = og / nx;
            if (og + 1u == (tg + 1u) * nx) xb_add(&bar[XB_TOPGEN], 1u);
            else XB_SPIN(xb_ld(&bar[XB_TOPGEN]) == tg, bar);
            __builtin_amdgcn_fence(__ATOMIC_ACQUIRE, "agent");
            xb_add(&bar[XB_XGEN(b.x)], 1u);
            asm volatile("s_waitcnt vmcnt(0)" ::: "memory");
        } else {
            XB_SPIN(xb_ld(&bar[XB_XGEN(b.x)]) == gen, bar);
            __builtin_amdgcn_fence(__ATOMIC_ACQUIRE, "agent");
            asm volatile("s_waitcnt vmcnt(0)" ::: "memory");
        }
    }
    __syncthreads();
}


__device__ __forceinline__ void run_phase(KP p, int ph, unsigned char* lds) {
  LAS unsigned char* ldsl = (LAS unsigned char*)lds;
  float* ldsf = (float*)lds;
  pg8::Sched S;
  if (ph == 0) {
    phase_conv(p, 0, ldsf);
    phase_dftm(p, ldsf);
    phase_prep(p);
    phase_hid(p, 0);
    return;
  }
  const int l = (ph - 1) / 17, k = (ph - 1) % 17;
#define WSDEF unsigned char* ws = p->ws; asm volatile("" : "+s"(ws)); bf16_t* wb = (bf16_t*)ws;
  switch (k) {
    case 0: case 14: { WSDEF
      if (l == 1) {
        pg8::EpiSwiGLU E{(bf16_t*)(ws + A_H), nullptr, 1.0f / (F8_SA * F8_SW), k == 14 ? 1 : 0};
        S.init(0, ws + O_XB8, wb + (k == 0 ? O_WGU1 : O_WGU2) / 2, DM / 2, DM / 2, NTOK, 2 * DFF, 0); pg8::gemm_phase<pg8::EpiSwiGLU, true>(ldsl, S, DM / 128, E);
      } else {
        pg8::EpiSwiGLU E{(bf16_t*)(ws + A_H), (const float*)(ws + O_RSTD), 1.0f, 0};
        S.init(0, ws + O_XB, wb + (k == 0 ? O_WGU1 : O_WGU2) / 2, DM, DM, NTOK, 2 * DFF, 0); pg8::gemm_phase(ldsl, S, DM / 64, E);
      } } break;
    case 1: case 15: { WSDEF
      if (k == 15 && l == 1) {
        pg8::EpiY E{(bf16_t*)(ws + A_Y), (float*)(ws + O_PART), 1.0f / (F8_SH * F8_SW)};
        S.init(0, ws + A_H, wb + O_WD2 / 2, DFF / 2, DFF / 2, NTOK, DM, 0); pg8::gemm_phase<pg8::EpiY, true>(ldsl, S, DFF / 128, E);
      } else {
        pg8::EpiY E{(bf16_t*)(ws + A_Y), (float*)(ws + O_PART), 1.0f};
        S.init(0, ws + A_H, wb + (k == 1 ? O_WD1 : O_WD2) / 2, DFF, DFF, NTOK, DM, 0); pg8::gemm_phase(ldsl, S, DFF / 64, E);
      } } break;
    case 2: phase_resid(p, (l == 0) ? p->in[0] : p->out, inl(p, 5, l), 0.5f, false); break;
    case 3: { WSDEF
      { pg8::EpiColBf16 E{(bf16_t*)(ws + A_HTFT), (const float*)(ws + O_RSTD), 1}; S.init(0, wb + O_WINT / 2, ws + O_XB, DM, DM, 4096, NTOK, 0); pg8::gemm_phase(ldsl, S, DM / 64, E); }
      { pg8::EpiRowBf16 E{(bf16_t*)(ws + A_PN), 6656, (const float*)(ws + O_RSTD), 1, 512}; S.init(0, ws + O_XB, wb + O_WINN / 2, DM, DM, NTOK, 6656, 0); pg8::gemm_phase(ldsl, S, DM / 64, E); }
      { pg8::EpiRowBf16 E{(bf16_t*)(ws + O_KB), DM, (const float*)(ws + O_RSTDM), 0, 0}; S.init(0, ws + O_MB, wb + O_WK / 2, DM, DM, MEMROWS, DM, 0); S.c = (S.c + 128) & 255; pg8::gemm_phase(ldsl, S, DM / 64, E); }
      { pg8::EpiColBf16 E{(bf16_t*)(ws + O_VT), (const float*)(ws + O_RSTDM), 0}; S.init(0, wb + O_WV / 2, ws + O_MB, DM, DM, DM, MEMROWS, 0); S.c = (S.c + 96) & 255; pg8::gemm_phase(ldsl, S, DM / 64, E); }
      { pg8::EpiFilt E{(float*)(ws + A_MB16)}; S.init(0, ws + O_W4T, ws + O_HIDB, 256, 256, 4096, 4096, 0); pg8::gemm_phase(ldsl, S, 256 / 64, E); }
    } break;
    case 4: { WSDEF
#ifndef NO_HYENA
      phase_hyena(p, l, lds);
#endif
      pg8::EpiRowBf16 E{(bf16_t*)(ws + A_ZCAT), 2560, nullptr, 0, 0}; S.init(3, ws + O_DFTM, ws + A_HTFT + (size_t)3072 * NTOK * 2, 8192, 8192, 256 * 16, 256 * 16, 0); pg8::gemm_phase(ldsl, S, 4096 / 64, E);
    } break;
    case 5: phase_poolt(p, lds); break;
    case 6: { WSDEF
      float* MF = (float*)(ws + A_MF); bf16_t* MB16 = (bf16_t*)(ws + A_MB16); const bf16_t* PN = (const bf16_t*)(ws + A_PN);
      { pg8::EpiMerge<0> E{MF, MB16, PN}; S.init(0, ws + A_ZCAT, wb + O_WM / 2, 2560, 2560, NTOK, DM, 0); pg8::gemm_phase(ldsl, S, 1024 / 64, E); }
      { pg8::EpiMerge<1> E{MF, MB16, PN}; S.init(0, ws + A_ZCAT, wb + O_WM / 2, 2560, 2560, NTOK, DM, 1024); pg8::gemm_phase(ldsl, S, 1024 / 64, E); }
      { pg8::EpiMerge<2> E{MF, MB16, PN}; S.init(0, ws + A_ZCAT, wb + O_WM / 2, 2560, 2560, NTOK, DM, 2048); pg8::gemm_phase(ldsl, S, 512 / 64, E); }
    } break;
    case 7: case 12: { WSDEF
      pg8::EpiY E{(bf16_t*)(ws + A_Y), (float*)(ws + O_PART), 1.0f};
      S.init(0, ws + (k == 7 ? A_MB16 : A_O), wb + (k == 7 ? O_WOUT : O_WO) / 2, DM, DM, NTOK, DM, 0); pg8::gemm_phase(ldsl, S, DM / 64, E); } break;
    case 8: phase_resid(p, p->out, inl(p, 24, l), 1.0f, false); break;
    case 9: { WSDEF pg8::EpiRowBf16 E{(bf16_t*)(ws + A_Q), DM, (const float*)(ws + O_RSTD), 0, 0}; S.init(0, ws + O_XB, wb + O_WQ / 2, DM, DM, NTOK, DM, 0); pg8::gemm_phase(ldsl, S, DM / 64, E); } break;
    case 10: { WSDEF pg8::EpiSoftmax E{(bf16_t*)(ws + A_P), 0.044194173824159216f * 1.4426950408889634f}; S.init(1, ws + A_Q, ws + O_KB, DM, DM, 256 * 16, 256 * 16, 0); pg8::gemm_phase(ldsl, S, 512 / 64, E); } break;
    case 11: { WSDEF pg8::EpiRowBf16 E{(bf16_t*)(ws + A_O), DM, nullptr, 0, 0}; S.init(2, ws + A_P, ws + O_VT, 1024, 1024, 256 * 32, 256 * 16, 0); pg8::gemm_phase(ldsl, S, 256 / 64, E); } break;
    case 13: phase_resid(p, p->out, inl(p, 30, l), 1.0f, l == 1); break;
    case 16: phase_resid(p, p->out, inl(p, 34, l), 0.5f, l == 0);
#ifndef NO_CONV
      if (l == 0) { phase_conv(p, 1, ldsf); phase_hid(p, 1); }
#endif
      break;
    default: break;
  }
}

__global__ void __launch_bounds__(512, 2) mk_fwd(Params p) {
  unsigned char* lds = g_lds;
  cg::grid_group grid = cg::this_grid();
  volatile LAS unsigned* st = (volatile LAS unsigned*)((LAS unsigned char*)lds + (LDS_BYTES - 16));
  { const int tid0 = (int)threadIdx.x;
    const unsigned hw = (unsigned)__builtin_amdgcn_s_getreg(((6 - 1) << 11) | 4) & 63u;
    if ((tid0 & 63) == 0) *(volatile LAS int*)((LAS unsigned char*)lds + WTAB_OFF + hw * 4) = tid0 >> 6;
    if (tid0 == 0) { st[0] = 0u; st[1] = 0u; } }
  __syncthreads();
  const XcdBarrier xb = xcd_barrier_post((unsigned*)(p.ws + O_BAR), st);
#ifndef REP_K
#define REP_K -1
#endif
  { KP kp = (KP)__builtin_amdgcn_kernarg_segment_ptr(); asm volatile("" : "+s"(kp));
    run_phase(kp, 0, lds); }
  grid.sync();
  for (int ph = 1; ph < 35; ++ph) {
    int nrep = 1;
    if (REP_K >= 0 && REP_K < 17 && (ph - 1) % 17 == REP_K && (REP_K != 2 || ph < 18)) nrep = 2;
    for (int r = 0; r < nrep; ++r) {
      KP kp = (KP)__builtin_amdgcn_kernarg_segment_ptr(); asm volatile("" : "+s"(kp));
      run_phase(kp, ph, lds);
      if (ph != 34 || r != nrep - 1) xcd_barrier(xb);
    }
  }
}

extern "C" void kernel_launch(void* const* d_in, const int* in_sizes, int n_in, void* d_out, int out_size,
                              void* d_ws, size_t ws_size, hipStream_t stream) {
  static int grid_blocks = 0;
  if (!grid_blocks) {
    int dev = 0, cus = 0, per_cu = 0;
    (void)hipGetDevice(&dev);
    (void)hipDeviceGetAttribute(&cus, hipDeviceAttributeMultiprocessorCount, dev);
    (void)hipFuncSetAttribute((const void*)mk_fwd, hipFuncAttributeMaxDynamicSharedMemorySize, LDS_BYTES);
    (void)hipOccupancyMaxActiveBlocksPerMultiprocessor(&per_cu, (const void*)mk_fwd, 512, LDS_BYTES);
    if (per_cu < 1) per_cu = 1;
    grid_blocks = cus * per_cu;
    if (grid_blocks != 256 || ws_size < A_END || n_in != NIN)
      fprintf(stderr, "kernel_launch: unexpected configuration: grid %d (cus %d x %d), ws %zu (need %zu), n_in %d\n", grid_blocks, cus, per_cu, ws_size, (size_t)A_END, n_in);
  }
  (void)hipMemsetAsync((char*)d_ws + O_BAR, 0, 16384, stream);
  Params p{};
  for (int i = 0; i < NIN; ++i) { p.in[i] = (const float*)d_in[i]; p.lsz[i] = in_sizes[i] / 2; }
  p.out = (float*)d_out; p.ws = (unsigned char*)d_ws; p.pad = 0;
  void* args[] = {&p};
  hipError_t e = hipLaunchCooperativeKernel((void*)mk_fwd, dim3(grid_blocks), dim3(512), args, LDS_BYTES, stream);
  if (e != hipSuccess) fprintf(stderr, "cooperative launch failed: %s (grid %d)\n", hipGetErrorString(e), grid_blocks);
}
```
